# Optimizing an MI355X kernel written in HIP

```python
import math
import jax, jax.numpy as jnp
from jax import lax
import numpy as np

D_MODEL = 1024
BATCH = 2
SEQ = 8192
DEPTH = 1

CHUNK = 64
D_MIX = D_MODEL
D_GMLP = D_MIX // 2
D_DIFF = D_MIX - D_GMLP
GM_GROUPS = 4
GM_GROUP_DIM = D_GMLP // GM_GROUPS
GM_WINDOW = 128
DIFF_HEADS = 4
DIFF_HEAD_DIM = D_DIFF // (2 * DIFF_HEADS)
DIFF_V_DIM = 2 * DIFF_HEAD_DIM
Q_BLOCK = 128
ROPE_THETA = 10000.0
EPS = 1e-6
MAX_OFFSET = 4096
SPLITS = [D_GMLP, 2 * D_GMLP, 3 * D_GMLP,
          3 * D_GMLP + D_DIFF, 3 * D_GMLP + 2 * D_DIFF, 3 * D_GMLP + 3 * D_DIFF]
D_IN = 3 * D_GMLP + 4 * D_DIFF

kernel_name = "hybrid_gmlp_diffattn_block"


def rms_norm(x, g):
    xf = x.astype(jnp.float32)
    y = xf * lax.rsqrt(jnp.mean(xf * xf, axis=-1, keepdims=True) + EPS)
    return (y * g.astype(jnp.float32)).astype(x.dtype)


def layer_norm(x, g, b):
    xf = x.astype(jnp.float32)
    mu = jnp.mean(xf, axis=-1, keepdims=True)
    xc = xf - mu
    y = xc * lax.rsqrt(jnp.mean(xc * xc, axis=-1, keepdims=True) + EPS)
    return (y * g.astype(jnp.float32) + b.astype(jnp.float32)).astype(x.dtype)


def rope(x, positions):
    d = x.shape[-1]
    half = d // 2
    inv = ROPE_THETA ** (-jnp.arange(half, dtype=jnp.float32) * 2.0 / d)
    ang = positions.astype(jnp.float32)[:, :, None] * inv
    cos = jnp.cos(ang)[:, :, None, None, :]
    sin = jnp.sin(ang)[:, :, None, None, :]
    xf = x.astype(jnp.float32)
    x1, x2 = xf[..., :half], xf[..., half:]
    out = jnp.concatenate([x1 * cos - x2 * sin, x2 * cos + x1 * sin], axis=-1)
    return out.astype(x.dtype)


def gmlp_branch(u, v, z, ln_g, ln_b, ws, bs):
    B, S, _ = u.shape
    u = jax.nn.gelu(u, approximate=False)
    v = jax.nn.gelu(v, approximate=False)
    v = layer_norm(v.reshape(B, S, GM_GROUPS, GM_GROUP_DIM),
                   ln_g.reshape(GM_GROUPS, GM_GROUP_DIM), ln_b.reshape(GM_GROUPS, GM_GROUP_DIM))
    v = v.reshape(B, S // GM_WINDOW, GM_WINDOW, GM_GROUPS, GM_GROUP_DIM)
    pos_chunk = jnp.arange(GM_WINDOW) // CHUNK
    mask = pos_chunk[:, None] >= pos_chunk[None, :]
    ws_m = jnp.where(mask[None], ws, jnp.zeros((), ws.dtype))
    sv = jnp.einsum('gij,bnjgc->bnigc', ws_m, v) + bs.T[None, None, :, :, None]
    sv = sv.reshape(B, S, D_GMLP)
    return u * sv * jax.nn.silu(z)


def diff_attention(q, k, v, z, positions, lq1, lk1, lq2, lk2, subln_g, lam_init):
    B, S, _ = q.shape
    q = rope(q.reshape(B, S, DIFF_HEADS, 2, DIFF_HEAD_DIM), positions) * (DIFF_HEAD_DIM ** -0.5)
    k = rope(k.reshape(B, S, DIFF_HEADS, 2, DIFF_HEAD_DIM), positions)
    v = v.reshape(B, S, DIFF_HEADS, DIFF_V_DIM)
    lam = (jnp.exp(jnp.sum(lq1.astype(jnp.float32) * lk1.astype(jnp.float32)))
           - jnp.exp(jnp.sum(lq2.astype(jnp.float32) * lk2.astype(jnp.float32))) + lam_init)
    nqb = S // Q_BLOCK
    q_blocks = q.reshape(B, nqb, Q_BLOCK, DIFF_HEADS, 2, DIFF_HEAD_DIM).transpose(1, 0, 2, 3, 4, 5)
    key_chunk = jnp.arange(S) // CHUNK

    def block(args):
        qb, i = args
        q_chunk = (i * Q_BLOCK + jnp.arange(Q_BLOCK)) // CHUNK
        allowed = key_chunk[None, :] <= q_chunk[:, None]
        s = jnp.einsum('bqhtd,bkhtd->bhtqk', qb, k).astype(jnp.float32)
        s = jnp.where(allowed, s, -jnp.inf)
        p = jax.nn.softmax(s, axis=-1)
        a = p[:, :, 0] - lam * p[:, :, 1]
        return jnp.einsum('bhqk,bkhe->bqhe', a.astype(v.dtype), v)

    out = lax.map(block, (q_blocks, jnp.arange(nqb)))
    out = out.transpose(1, 0, 2, 3, 4).reshape(B, S, DIFF_HEADS, DIFF_V_DIM)
    out = rms_norm(out, subln_g) * (1.0 - lam_init)
    return out.reshape(B, S, D_DIFF) * jax.nn.silu(z)


def setup_inputs(seed: int = 0) -> dict:
    key = jax.random.key(seed)
    ks = jax.random.split(key, 20)
    f = jnp.float32
    x = jax.random.normal(ks[0], (BATCH, SEQ, D_MODEL), f)
    c = jax.random.normal(ks[1], (BATCH, D_MODEL), f)
    offset = jax.random.randint(ks[2], (BATCH, 1), 0, MAX_OFFSET, dtype=jnp.int32)
    positions = (offset + jnp.arange(SEQ, dtype=jnp.int32)[None, :]).astype(jnp.int32)
    w_ada = jax.random.normal(ks[3], (DEPTH, D_MODEL, 3 * D_MODEL), f) * (0.2 * D_MODEL ** -0.5)
    b_ada = jax.random.normal(ks[4], (DEPTH, 3 * D_MODEL), f) * 0.02
    norm_g = 1.0 + 0.02 * jax.random.normal(ks[5], (DEPTH, D_MODEL), f)
    w_in = jax.random.normal(ks[6], (DEPTH, D_MODEL, D_IN), f) * (D_MODEL ** -0.5)
    gm_ln_g = 1.0 + 0.02 * jax.random.normal(ks[7], (DEPTH, D_GMLP), f)
    gm_ln_b = 0.02 * jax.random.normal(ks[8], (DEPTH, D_GMLP), f)
    gm_ws = jax.random.normal(ks[9], (DEPTH, GM_GROUPS, GM_WINDOW, GM_WINDOW), f) * (GM_WINDOW ** -0.5)
    gm_bs = 1.0 + 0.02 * jax.random.normal(ks[10], (DEPTH, GM_GROUPS, GM_WINDOW), f)
    lam_q1 = 0.1 * jax.random.normal(ks[11], (DEPTH, DIFF_HEAD_DIM), f)
    lam_k1 = 0.1 * jax.random.normal(ks[12], (DEPTH, DIFF_HEAD_DIM), f)
    lam_q2 = 0.1 * jax.random.normal(ks[13], (DEPTH, DIFF_HEAD_DIM), f)
    lam_k2 = 0.1 * jax.random.normal(ks[14], (DEPTH, DIFF_HEAD_DIM), f)
    diff_subln_g = 1.0 + 0.02 * jax.random.normal(ks[15], (DEPTH, DIFF_V_DIM), f)
    w_out = jax.random.normal(ks[16], (DEPTH, D_MIX, D_MODEL), f) * (D_MIX ** -0.5)
    final_g = 1.0 + 0.02 * jax.random.normal(ks[17], (D_MODEL,), f)
    return {"x": x, "c": c, "positions": positions, "w_ada": w_ada, "b_ada": b_ada,
            "norm_g": norm_g, "w_in": w_in, "gm_ln_g": gm_ln_g, "gm_ln_b": gm_ln_b,
            "gm_ws": gm_ws, "gm_bs": gm_bs, "lam_q1": lam_q1, "lam_k1": lam_k1,
            "lam_q2": lam_q2, "lam_k2": lam_k2, "diff_subln_g": diff_subln_g,
            "w_out": w_out, "final_g": final_g}


def reference(x, c, positions, w_ada, b_ada, norm_g, w_in, gm_ln_g, gm_ln_b, gm_ws, gm_bs,
              lam_q1, lam_k1, lam_q2, lam_k2, diff_subln_g, w_out, final_g):
    cs = jax.nn.silu(c)
    for l in range(DEPTH):
        mod = cs @ w_ada[l] + b_ada[l]
        shift, scale, gate = jnp.split(mod, 3, axis=-1)
        h = rms_norm(x, norm_g[l]) * (1.0 + scale[:, None, :]) + shift[:, None, :]
        proj = h @ w_in[l]
        u, v, z_a, q, k, v_d, z_b = jnp.split(proj, SPLITS, axis=-1)
        y_a = gmlp_branch(u, v, z_a, gm_ln_g[l], gm_ln_b[l], gm_ws[l], gm_bs[l])
        lam_init = 0.8 - 0.6 * math.exp(-0.3 * l)
        y_b = diff_attention(q, k, v_d, z_b, positions, lam_q1[l], lam_k1[l], lam_q2[l], lam_k2[l],
                             diff_subln_g[l], lam_init)
        y = jnp.concatenate([y_a, y_b], axis=-1) @ w_out[l]
        x = x + gate[:, None, :] * y
    return rms_norm(x, final_g)
```

```cpp
#include <hip/hip_runtime.h>
#include <cstdint>
#include <cstdio>

constexpr int BATCH = 2, SEQ = 8192, DM = 1024, M = BATCH * SEQ;
constexpr int DG = 512, DD = 512, DIN = 3584;
constexpr int NH = 4, HD = 64, VD = 128;
constexpr float EPS = 1e-6f;
constexpr float LAM_INIT = 0.2f;

typedef unsigned short bf16_t;
__device__ __forceinline__ unsigned f2bf(float f) { unsigned u = __builtin_bit_cast(unsigned, f); return (u + 0x7fffu + ((u >> 16) & 1u)) >> 16; }
__device__ __forceinline__ float bf2f(bf16_t b) { return __builtin_bit_cast(float, (unsigned)b << 16); }

__device__ const double INV_REV[32] = {0.15915494309189535, 0.11934937021124886, 0.08949940160889101, 0.06711508300522726, 0.050329212104487035, 0.03774158471741977, 0.0283021958306234, 0.02122365276477766, 0.015915494309189534, 0.011934937021124886, 0.008949940160889102, 0.006711508300522725, 0.005032921210448704, 0.003774158471741977, 0.00283021958306234, 0.0021223652764777662, 0.0015915494309189536, 0.0011934937021124885, 0.0008949940160889102, 0.0006711508300522726, 0.0005032921210448703, 0.00037741584717419774, 0.00028302195830623395, 0.0002122365276477766, 0.00015915494309189535, 0.00011934937021124886, 8.949940160889102e-05, 6.711508300522725e-05, 5.0329212104487035e-05, 3.774158471741978e-05, 2.8302195830623396e-05, 2.122365276477766e-05};

__device__ __forceinline__ float silu_f(float z) { return z / (1.f + __expf(-z)); }
__device__ __forceinline__ float gelu_f(float v) { return 0.5f * v * (1.f + erff(v * 0.70710678118654752f)); }

__global__ void k_mod(const float* c, const float* w_ada, const float* b_ada, float* mod) {
    const int n = blockIdx.x * 256 + threadIdx.x, b = blockIdx.y;
    float acc = 0.f;
    for (int k = 0; k < DM; ++k) acc += silu_f(c[b * DM + k]) * w_ada[(size_t)k * 3 * DM + n];
    mod[b * 3 * DM + n] = acc + b_ada[n];
}
__global__ void k_rope(const int* pos, float2* cs) {
    const int idx = blockIdx.x * 256 + threadIdx.x; if (idx >= M * 32) return;
    const int m = idx >> 5, i = idx & 31;
    const double rev = (double)pos[m] * INV_REV[i];
    const double fr = rev - __builtin_rint(rev);
    const float ang = (float)(fr * 6.283185307179586476925);
    cs[idx] = make_float2(cosf(ang), sinf(ang));
}
__global__ void k_h(const float* x, const float* g, const float* mod, float* h) {
    __shared__ float red[256];
    const int m = blockIdx.x, b = m / SEQ, t = threadIdx.x;
    const float* xr = x + (size_t)m * DM; float v[4]; float s = 0.f;
    for (int j = 0; j < 4; ++j) { v[j] = xr[t + 256 * j]; s += v[j] * v[j]; }
    red[t] = s; __syncthreads();
    for (int o = 128; o > 0; o >>= 1) { if (t < o) red[t] += red[t + o]; __syncthreads(); }
    const float rinv = 1.f / sqrtf(red[0] / DM + EPS);
    const float* shift = mod + b * 3 * DM; const float* scale = shift + DM;
    for (int j = 0; j < 4; ++j) { const int k = t + 256 * j; h[(size_t)m * DM + k] = v[j] * rinv * g[k] * (1.f + scale[k]) + shift[k]; }
}
template <int MODE> __launch_bounds__(256)
__global__ void k_gemm(const float* A, const float* B, int K, int N, bf16_t* Cb, float* Cf, const float* x, const float* mod) {
    __shared__ float As[16][65], Bs[16][64];
    const int t = threadIdx.x, tx = t & 15, ty = t >> 4, m0 = blockIdx.y * 64, n0 = blockIdx.x * 64;
    float acc[4][4] = {};
    for (int k0 = 0; k0 < K; k0 += 16) {
        for (int i = t; i < 64 * 16; i += 256) { const int r = i >> 4, kk = i & 15; As[kk][r] = A[(size_t)(m0 + r) * K + k0 + kk]; }
        for (int i = t; i < 16 * 64; i += 256) { const int kk = i >> 6, cidx = i & 63; Bs[kk][cidx] = B[(size_t)(k0 + kk) * N + n0 + cidx]; }
        __syncthreads();
#pragma unroll
        for (int kk = 0; kk < 16; ++kk) {
            float a[4], bb[4];
#pragma unroll
            for (int i = 0; i < 4; ++i) { a[i] = As[kk][ty * 4 + i]; bb[i] = Bs[kk][tx * 4 + i]; }
#pragma unroll
            for (int i = 0; i < 4; ++i)
#pragma unroll
                for (int j = 0; j < 4; ++j) acc[i][j] += a[i] * bb[j];
        }
        __syncthreads();
    }
    for (int i = 0; i < 4; ++i) for (int j = 0; j < 4; ++j) {
        const int m = m0 + ty * 4 + i, n = n0 + tx * 4 + j;
        if (MODE == 0) Cb[(size_t)m * N + n] = (bf16_t)f2bf(acc[i][j]);
        else { const int b = m / SEQ; const float gate = mod[b * 3 * DM + 2 * DM + n]; Cf[(size_t)m * N + n] = x[(size_t)m * N + n] + gate * acc[i][j]; }
    }
}
__global__ void __launch_bounds__(128) k_gmlp(const bf16_t* proj, const float* ln_g, const float* ln_b, const float* ws, const float* bs, float* Y) {
    extern __shared__ float sm[];
    float* vt = sm;
    float* mean = sm + 128 * 128; float* rstd = mean + 128;
    const int win = blockIdx.x, g = blockIdx.y, t = threadIdx.x; const size_t row0 = (size_t)win * 128;
    {
        const bf16_t* vr = proj + (row0 + t) * DIN + DG + g * 128; float s = 0.f;
        for (int cc = 0; cc < 128; ++cc) s += gelu_f(bf2f(vr[cc]));
        const float mu = s / 128.f; float q = 0.f;
        for (int cc = 0; cc < 128; ++cc) { const float d = gelu_f(bf2f(vr[cc])) - mu; q += d * d; }
        mean[t] = mu; rstd[t] = 1.f / sqrtf(q / 128.f + EPS);
    }
    __syncthreads();
    const int c = t; const float gg = ln_g[g * 128 + c], bb = ln_b[g * 128 + c];
    for (int j = 0; j < 128; ++j) vt[j * 128 + c] = (gelu_f(bf2f(proj[(row0 + j) * DIN + DG + g * 128 + c])) - mean[j]) * rstd[j] * gg + bb;
    __syncthreads();
    for (int i = 0; i < 128; ++i) {
        const float* w = ws + ((size_t)g * 128 + i) * 128; float acc = 0.f;
        const int jmax = (i < 64) ? 64 : 128;
        for (int j = 0; j < jmax; ++j) acc += w[j] * vt[j * 128 + c];
        const float sv = acc + bs[g * 128 + i];
        const float u = gelu_f(bf2f(proj[(row0 + i) * DIN + g * 128 + c]));
        const float z = bf2f(proj[(row0 + i) * DIN + 2 * DG + g * 128 + c]);
        Y[(row0 + i) * DM + g * 128 + c] = u * sv * silu_f(z);
    }
}
__global__ void __launch_bounds__(256) k_attn(const bf16_t* proj, const float2* cs, const float* lq1, const float* lk1, const float* lq2, const float* lk2, const float* subg, float* Y) {
    extern __shared__ float sm[];
    float* qs = sm;
    float* ks = qs + 64 * 129;
    float* vs = ks + 64 * 128;
    const int qc = blockIdx.x, bh = blockIdx.y, b = bh / NH, h = bh % NH, t = threadIdx.x, r = t >> 2, part = t & 3;
    const size_t rowb = (size_t)b * SEQ;
    float lam; { float s1 = 0.f, s2 = 0.f; for (int d = 0; d < HD; ++d) { s1 += lq1[d] * lk1[d]; s2 += lq2[d] * lk2[d]; } lam = expf(s1) - expf(s2) + LAM_INIT; }
    for (int i = t; i < 64 * 64; i += 256) { const int rr = i >> 6, e = i & 63, tc = e >> 5, d = e & 31;
        const size_t m = rowb + qc * 64 + rr; const bf16_t* qp = proj + m * DIN + 3 * DG + h * 128 + tc * 64;
        const float x1 = bf2f(qp[d]), x2 = bf2f(qp[d + 32]); const float2 c2 = cs[m * 32 + d];
        qs[rr * 129 + tc * 64 + d] = (x1 * c2.x - x2 * c2.y) * 0.125f; qs[rr * 129 + tc * 64 + d + 32] = (x2 * c2.x + x1 * c2.y) * 0.125f; }
    float m0 = -INFINITY, m1 = -INFINITY;
    const int nkt = qc + 1;
    for (int pass = 0; pass < 2; ++pass) {
        float l0 = 0.f, l1 = 0.f, o0[32], o1[32];
#pragma unroll
        for (int e = 0; e < 32; ++e) { o0[e] = 0.f; o1[e] = 0.f; }
        for (int kt = 0; kt < nkt; ++kt) {
            __syncthreads();
            for (int i = t; i < 64 * 64; i += 256) { const int rr = i >> 6, e = i & 63, tc = e >> 5, d = e & 31;
                const size_t m = rowb + kt * 64 + rr; const bf16_t* kp = proj + m * DIN + 3 * DG + DD + h * 128 + tc * 64;
                const float x1 = bf2f(kp[d]), x2 = bf2f(kp[d + 32]); const float2 c2 = cs[m * 32 + d];
                ks[rr * 128 + tc * 64 + d] = x1 * c2.x - x2 * c2.y; ks[rr * 128 + tc * 64 + d + 32] = x2 * c2.x + x1 * c2.y; }
            for (int i = t; i < 64 * 128; i += 256) { const int rr = i >> 7, e = i & 127; vs[i] = bf2f(proj[(rowb + kt * 64 + rr) * DIN + 3 * DG + 2 * DD + h * 128 + e]); }
            __syncthreads();
            for (int j = 0; j < 64; ++j) {
                float s0 = 0.f, s1 = 0.f;
                for (int d = 0; d < 16; ++d) { s0 += qs[r * 129 + part * 16 + d] * ks[j * 128 + part * 16 + d]; s1 += qs[r * 129 + 64 + part * 16 + d] * ks[j * 128 + 64 + part * 16 + d]; }
                s0 += __shfl_xor(s0, 1); s0 += __shfl_xor(s0, 2); s1 += __shfl_xor(s1, 1); s1 += __shfl_xor(s1, 2);
                if (pass == 0) { m0 = fmaxf(m0, s0); m1 = fmaxf(m1, s1); }
                else { const float p0 = __expf(s0 - m0), p1 = __expf(s1 - m1); l0 += p0; l1 += p1;
#pragma unroll
                    for (int e = 0; e < 32; ++e) { const float v = vs[j * 128 + part * 32 + e]; o0[e] += p0 * v; o1[e] += p1 * v; } }
            }
        }
        if (pass == 1) {
            float d[32]; float ss = 0.f;
#pragma unroll
            for (int e = 0; e < 32; ++e) { d[e] = o0[e] / l0 - lam * o1[e] / l1; ss += d[e] * d[e]; }
            ss += __shfl_xor(ss, 1); ss += __shfl_xor(ss, 2);
            const float rinv = 1.f / sqrtf(ss / 128.f + EPS);
            const size_t m = rowb + qc * 64 + r;
#pragma unroll
            for (int e = 0; e < 32; ++e) { const int col = h * 128 + part * 32 + e; const float z = bf2f(proj[m * DIN + 3 * DG + 3 * DD + col]);
                Y[m * DM + DG + col] = d[e] * rinv * subg[part * 32 + e] * (1.f - LAM_INIT) * silu_f(z); }
        }
    }
}
__global__ void k_final(float* out, const float* g) {
    __shared__ float red[256];
    const int m = blockIdx.x, t = threadIdx.x; float* xr = out + (size_t)m * DM; float v[4]; float s = 0.f;
    for (int j = 0; j < 4; ++j) { v[j] = xr[t + 256 * j]; s += v[j] * v[j]; }
    red[t] = s; __syncthreads();
    for (int o = 128; o > 0; o >>= 1) { if (t < o) red[t] += red[t + o]; __syncthreads(); }
    const float rinv = 1.f / sqrtf(red[0] / DM + EPS);
    for (int j = 0; j < 4; ++j) xr[t + 256 * j] = v[j] * rinv * g[t + 256 * j];
}

extern "C" void kernel_launch(void* const* d_in, const int* in_sizes, int n_in, void* d_out, int out_size, void* d_ws, size_t ws_size, hipStream_t stream) {
    const float* x = (const float*)d_in[0]; const float* c = (const float*)d_in[1]; const int* pos = (const int*)d_in[2];
    const float* w_ada = (const float*)d_in[3]; const float* b_ada = (const float*)d_in[4]; const float* norm_g = (const float*)d_in[5];
    const float* w_in = (const float*)d_in[6]; const float* ln_g = (const float*)d_in[7]; const float* ln_b = (const float*)d_in[8];
    const float* gws = (const float*)d_in[9]; const float* gbs = (const float*)d_in[10];
    const float* lq1 = (const float*)d_in[11]; const float* lk1 = (const float*)d_in[12]; const float* lq2 = (const float*)d_in[13]; const float* lk2 = (const float*)d_in[14];
    const float* subg = (const float*)d_in[15]; const float* w_out = (const float*)d_in[16]; const float* fin_g = (const float*)d_in[17];
    float* out = (float*)d_out; char* ws = (char*)d_ws;
    bf16_t* proj = (bf16_t*)ws;
    float* Y = (float*)(ws + (size_t)128 * 1024 * 1024);
    float* h = (float*)(ws + (size_t)192 * 1024 * 1024);
    float* mod = (float*)(ws + (size_t)120 * 1024 * 1024);
    float2* cs = (float2*)(ws + (size_t)121 * 1024 * 1024);
    static bool attr = false;
    if (!attr) { hipFuncSetAttribute((const void*)k_attn, hipFuncAttributeMaxDynamicSharedMemorySize, 100000); hipFuncSetAttribute((const void*)k_gmlp, hipFuncAttributeMaxDynamicSharedMemorySize, 70000); attr = true; }
    k_mod<<<dim3(3 * DM / 256, BATCH), 256, 0, stream>>>(c, w_ada, b_ada, mod);
    k_rope<<<M * 32 / 256, 256, 0, stream>>>(pos, cs);
    k_h<<<M, 256, 0, stream>>>(x, norm_g, mod, h);
    k_gemm<0><<<dim3(DIN / 64, M / 64), 256, 0, stream>>>(h, w_in, DM, DIN, proj, nullptr, nullptr, nullptr);
    k_gmlp<<<dim3(M / 128, 4), 128, (128 * 128 + 256) * 4, stream>>>(proj, ln_g, ln_b, gws, gbs, Y);
    k_attn<<<dim3(SEQ / 64, BATCH * NH), 256, (64 * 129 + 2 * 64 * 128) * 4, stream>>>(proj, cs, lq1, lk1, lq2, lk2, subg, Y);
    k_gemm<1><<<dim3(DM / 64, M / 64), 256, 0, stream>>>(Y, w_out, DM, DM, nullptr, out, x, mod);
    k_final<<<M, 256, 0, stream>>>(out, fin_g);
}
```

```cpp
#include <hip/hip_runtime.h>
#include <cstdio>
#include <cstdint>
#ifndef MK_N_LAUNCHES
#define MK_N_LAUNCHES 1
#endif
constexpr int BATCH = 2, SEQ = 8192, DM = 1024, M = BATCH * SEQ;
constexpr int DG = 512, DD = 512, DIN = 3584, NBUF = 7;
constexpr int NH = 4, HD = 64, VD = 128;
constexpr float EPS = 1e-6f, LAM_INIT = 0.2f;
constexpr float QSCALE = 0.125f * 1.4426950408889634f;
constexpr size_t BUF_STRIDE = (size_t)M * 512;
namespace pg8 {
#define PG8_LAS __attribute__((address_space(3)))
typedef unsigned short bf16_t;
typedef short bf16x8 __attribute__((ext_vector_type(8)));
typedef float f32x4 __attribute__((ext_vector_type(4)));
typedef unsigned u32x4 __attribute__((ext_vector_type(4)));
constexpr int BM = 256, BK = 64, HALF = 128, HTB = HALF * BK * 2  , STAGE_BYTES = 8 * HTB, NXCD = 8, WGM = 8;

__host__ __device__ __forceinline__ int lds_byte(int r, int c) { const int st = (r >> 4) * 2 + (c >> 5), rr = r & 15, cc = c & 31, ob = rr * 64 + cc * 2; return st * 1024 + (ob ^ (((ob >> 9) & 1) << 5)); }
__host__ __device__ __forceinline__ void stage_rc(int b, int& R, int& C) { const int st = b / 1024, sb = b % 1024, swz = sb ^ (((sb >> 9) & 1) << 5); R = (st >> 1) * 16 + swz / 64; C = (st & 1) * 32 + (swz % 64) / 2; }
__host__ __device__ __forceinline__ int perm32(int rho) { const int n = rho >> 4, i = rho & 15; return 8 * (i >> 2) + 4 * n + (i & 3); }

struct Unit { int pm, pn; };
struct Gemm { const bf16_t* A; const bf16_t* Bt; int M, N, K; };

struct StaticOrder {
    int nM, nN, nwg, G, c;
    __host__ __device__ void init(int M, int N, int G_, int c_) { nM = M / BM; nN = N / BM; nwg = nM * nN; G = G_; c = c_; }
    __host__ __device__ bool next(int i, Unit& u) const {
        const long L = (long)i * G + c; if (L >= nwg) return false;
        int wgid = (int)L; { const int q = nwg / NXCD, r = nwg % NXCD, xcd = wgid % NXCD, off = wgid / NXCD; wgid = (xcd < r ? xcd * (q + 1) : r * (q + 1) + (xcd - r) * q) + off; }
        const int nig = WGM * nN, gid = wgid / nig, fm = gid * WGM, gsz = (nM - fm) < WGM ? (nM - fm) : WGM;
        u.pm = fm + ((wgid % nig) % gsz); u.pn = (wgid % nig) / gsz; return true;
    }
    __device__ __forceinline__ void a_ready(const Unit&) const {}
    __device__ __forceinline__ void done(const Unit&) const {}
};

__device__ __forceinline__ unsigned cvt_pk_bf16(float lo, float hi) { unsigned r; asm volatile("v_cvt_pk_bf16_f32 %0, %1, %2" : "=v"(r) : "v"(lo), "v"(hi)); return r; }
typedef float f32x2 __attribute__((ext_vector_type(2)));
__device__ __forceinline__ f32x2 gelu_pk(f32x2 v) {
    const f32x2 av = __builtin_elementwise_abs(v), d = av * 0.2316418882f + 1.0f;
    f32x2 t; t.x = __builtin_amdgcn_rcpf(d.x); t.y = __builtin_amdgcn_rcpf(d.y);
    f32x2 q = t * 0.5307027145f + (-0.7265760135f); q = q * t + 0.7107068705f; q = q * t + (-0.142248368f); q = q * t + 0.127414796f; q = q * t;
    const f32x2 s = (v * v) * (-0.72134752044f);
    f32x2 e; e.x = __builtin_amdgcn_exp2f(s.x); e.y = __builtin_amdgcn_exp2f(s.y);
    const f32x2 m = v * (q * e), r = v - m;
    f32x2 o; o.x = v.x < 0.f ? m.x : r.x; o.y = v.y < 0.f ? m.y : r.y; return o;
}
typedef unsigned u32x2 __attribute__((ext_vector_type(2)));
__device__ __forceinline__ float silu1(float v) { return v * __builtin_amdgcn_rcpf(1.0f + __builtin_amdgcn_exp2f(v * -1.4426950408889634f)); }
struct EpiProj {
    static constexpr bool PERM = true, AFTER_DRAIN = false;
    bf16_t* O; const float* cs;
    __device__ __forceinline__ void operator()(const f32x4 (&acc)[2][2][4][2], const Unit& u, int wr, int wc, int fr, int fq) const {
        const int t = u.pn >> 1, colt = (u.pn & 1) * BM;
        bf16_t* base = O + (size_t)t * BUF_STRIDE;
        const int row0 = u.pm * BM + wr * 64 + fr;
        if (t == 3 || t == 4) {
            const float sc = (t == 3) ? QSCALE : 1.0f;
            const int g = 4 * (wc & 1) + fq;
#pragma unroll
            for (int ai = 0; ai < 2; ++ai)
#pragma unroll
                for (int m = 0; m < 4; ++m) {
                    const int row = row0 + ai * HALF + m * 16;
                    const f32x4 cv = *(const f32x4*)(cs + (size_t)row * 64 + g * 8), sv = *(const f32x4*)(cs + (size_t)row * 64 + g * 8 + 4);
#pragma unroll
                    for (int bj = 0; bj < 2; ++bj) {
                        const f32x4 x1 = acc[ai][bj][m][0], x2 = acc[ai][bj][m][1];
                        const f32x4 o1 = (x1 * cv - x2 * sv) * sc, o2 = (x2 * cv + x1 * sv) * sc;
                        bf16_t* p = base + (size_t)row * 512 + colt + bj * HALF + (wc >> 1) * 64 + 4 * g;
                        u32x2 w1, w2; w1.x = cvt_pk_bf16(o1[0], o1[1]); w1.y = cvt_pk_bf16(o1[2], o1[3]); w2.x = cvt_pk_bf16(o2[0], o2[1]); w2.y = cvt_pk_bf16(o2[2], o2[3]);
                        *(u32x2*)p = w1; *(u32x2*)(p + 32) = w2;
                    }
                }
        } else {
            const int col0 = colt + wc * 32 + 8 * fq;
#pragma unroll
            for (int ai = 0; ai < 2; ++ai)
#pragma unroll
                for (int m = 0; m < 4; ++m) {
                    bf16_t* rowp = base + (size_t)(row0 + ai * HALF + m * 16) * 512 + col0;
#pragma unroll
                    for (int bj = 0; bj < 2; ++bj) {
                        f32x4 v0 = acc[ai][bj][m][0], v1 = acc[ai][bj][m][1];
                        if (t <= 1) { const f32x2 a = gelu_pk((f32x2){v0[0], v0[1]}), b = gelu_pk((f32x2){v0[2], v0[3]}), c = gelu_pk((f32x2){v1[0], v1[1]}), d = gelu_pk((f32x2){v1[2], v1[3]});
                            v0 = (f32x4){a.x, a.y, b.x, b.y}; v1 = (f32x4){c.x, c.y, d.x, d.y}; }
                        else if (t != 5) {
#pragma unroll
                            for (int e = 0; e < 4; ++e) { v0[e] = silu1(v0[e]); v1[e] = silu1(v1[e]); } }
                        u32x4 w; w.x = cvt_pk_bf16(v0[0], v0[1]); w.y = cvt_pk_bf16(v0[2], v0[3]); w.z = cvt_pk_bf16(v1[0], v1[1]); w.w = cvt_pk_bf16(v1[2], v1[3]);
                        *(u32x4*)(rowp + bj * HALF) = w;
                    }
                }
        }
    }
};
struct EpiOut {
    static constexpr bool PERM = false, AFTER_DRAIN = false;
    const float* x; float* out; const float* gate;
    __device__ __forceinline__ void operator()(const f32x4 (&acc)[2][2][4][2], const Unit& u, int wr, int wc, int fr, int fq) const {
        const int b = (u.pm * BM) / 8192, col0 = u.pn * BM + wc * 32 + 4 * fq;
        f32x4 gv[2][2];
#pragma unroll
        for (int bj = 0; bj < 2; ++bj)
#pragma unroll
            for (int n = 0; n < 2; ++n) gv[bj][n] = *(const f32x4*)(gate + b * 3072 + col0 + bj * HALF + n * 16);
#pragma unroll
        for (int ai = 0; ai < 2; ++ai)
#pragma unroll
            for (int m = 0; m < 4; ++m) {
                const size_t off = (size_t)(u.pm * BM + ai * HALF + wr * 64 + m * 16 + fr) * 1024 + col0;
#pragma unroll
                for (int bj = 0; bj < 2; ++bj)
#pragma unroll
                    for (int n = 0; n < 2; ++n) { const f32x4 xv = *(const f32x4*)(x + off + bj * HALF + n * 16); *(f32x4*)(out + off + bj * HALF + n * 16) = xv + gv[bj][n] * acc[ai][bj][m][n]; }
            }
    }
};

template <class Epi, class Sched, bool ALIGN_EPI = false, bool SP2 = false>
__device__ __forceinline__ void gemm_phase(PG8_LAS unsigned char* lds, const Gemm g, const Sched& S, const Epi& E) {
    const int tid = threadIdx.x, wid = __builtin_amdgcn_readfirstlane(tid >> 6), lane = tid & 63, wr = wid >> 2, wc = wid & 3, fr = lane & 15, fq = lane >> 4;
    const int K = g.K, nt = K / BK;
    unsigned voffA[2], voffB[2];
#pragma unroll
    for (int i = 0; i < 2; ++i) { int R, C; stage_rc(tid * 16 + i * 8192, R, C); const int Rb = Epi::PERM ? ((R & ~31) + perm32(R & 31)) : R;
        voffA[i] = (unsigned)(R * K + C) * 2u; voffB[i] = (unsigned)(Rb * K + C) * 2u; }
    const size_t kstep = (size_t)(BK * 2);
    const size_t hstep = (size_t)HALF * K * 2;
    const size_t tstep = 2 * hstep;
    const unsigned ldsw = (unsigned)wid * 1024u;
    const int aoff = lds_byte(wr * 64 + fr, fq * 8), boff = lds_byte(wc * 32 + fr, fq * 8);
#define PG8_SA(b, h) (((b) * 2 + (h)) * HTB)
#define PG8_SB(b, h) ((4 + (b) * 2 + (h)) * HTB)
#define PG8_STAGE(bufoff, gbase, voff) do { _Pragma("unroll") for (int _i = 0; _i < 2; ++_i) \
        __builtin_amdgcn_global_load_lds((const unsigned*)((const char*)(gbase) + (voff)[_i]), (PG8_LAS unsigned*)(lds + (bufoff) + ldsw + _i * 8192), 16, 0, 0); } while (0)
#define PG8_LDA(dst, b, h) do { _Pragma("unroll") for (int m = 0; m < 4; ++m) _Pragma("unroll") for (int k = 0; k < 2; ++k) dst[m][k] = *(const PG8_LAS bf16x8*)(lds + PG8_SA(b, h) + aoff + m * 2048 + k * 1024); } while (0)
#define PG8_LDB(dst, b, h) do { _Pragma("unroll") for (int n = 0; n < 2; ++n) _Pragma("unroll") for (int k = 0; k < 2; ++k) dst[n][k] = *(const PG8_LAS bf16x8*)(lds + PG8_SB(b, h) + boff + n * 2048 + k * 1024); } while (0)
#define PG8_MMA(ai, bj, At, Bt) do { __builtin_amdgcn_s_setprio(1); _Pragma("unroll") for (int m = 0; m < 4; ++m) _Pragma("unroll") for (int n = 0; n < 2; ++n) _Pragma("unroll") for (int k = 0; k < 2; ++k) \
        acc[ai][bj][m][n] = __builtin_amdgcn_mfma_f32_16x16x32_bf16(Bt[n][k], At[m][k], acc[ai][bj][m][n], 0, 0, 0); __builtin_amdgcn_s_setprio(0); } while (0)
#define PG8_WAIT_V(n) asm volatile("s_waitcnt vmcnt(" #n ")" ::: "memory")
#define PG8_WAIT_L(n) asm volatile("s_waitcnt lgkmcnt(" #n ")" ::: "memory")
#define PG8_BAR __builtin_amdgcn_s_barrier()
#define PG8_SCHED __builtin_amdgcn_sched_barrier(0)
    Unit cur, nxt; int ui = 0;
    if (!S.next(0, cur)) return;
    f32x4 acc[2][2][4][2];
#pragma unroll
    for (int a = 0; a < 2; ++a)
#pragma unroll
        for (int b = 0; b < 2; ++b)
#pragma unroll
            for (int m = 0; m < 4; ++m)
#pragma unroll
                for (int n = 0; n < 2; ++n) acc[a][b][m][n] = (f32x4){0.f, 0.f, 0.f, 0.f};
    bf16x8 At[4][2], B0[2][2], B1[2][2];
    const char* cA = (const char*)g.A + (size_t)cur.pm * tstep; const char* cB = (const char*)g.Bt + (size_t)cur.pn * tstep;
    S.a_ready(cur);
    if constexpr (SP2) {
        PG8_STAGE(PG8_SB(0, 0), cB, voffB); PG8_STAGE(PG8_SB(0, 1), cB + hstep, voffB); PG8_STAGE(PG8_SA(0, 0), cA, voffA); PG8_STAGE(PG8_SA(0, 1), cA + hstep, voffA);
        if (wr == 1) PG8_BAR;
        PG8_WAIT_V(2); PG8_BAR;
        PG8_STAGE(PG8_SB(1, 0), cB + kstep, voffB); PG8_STAGE(PG8_SA(1, 0), cA + kstep, voffA); PG8_STAGE(PG8_SB(1, 1), cB + hstep + kstep, voffB);
        PG8_WAIT_V(6); PG8_BAR;
    } else {
        PG8_STAGE(PG8_SB(0, 0), cB, voffB); PG8_STAGE(PG8_SA(0, 0), cA, voffA); PG8_STAGE(PG8_SB(0, 1), cB + hstep, voffB); PG8_STAGE(PG8_SA(0, 1), cA + hstep, voffA);
        if (wr == 1) PG8_BAR;
        PG8_WAIT_V(4); PG8_BAR;
        PG8_STAGE(PG8_SB(1, 0), cB + kstep, voffB); PG8_STAGE(PG8_SA(1, 0), cA + kstep, voffA); PG8_STAGE(PG8_SB(1, 1), cB + hstep + kstep, voffB);
        PG8_WAIT_V(6); PG8_BAR;
    }
    for (;;) {
        const bool has_next = S.next(ui + 1, nxt);
        const char* nA = has_next ? (const char*)g.A + (size_t)nxt.pm * tstep : cA; const char* nB = has_next ? (const char*)g.Bt + (size_t)nxt.pn * tstep : cB;
        for (int t = 0; t < nt; t += 2) {
            const bool last = (t == nt - 2);
            const char* a1 = cA + (size_t)(t + 1) * kstep;
            const char* a2 = last ? nA : cA + (size_t)(t + 2) * kstep; const char* b2 = last ? nB : cB + (size_t)(t + 2) * kstep;
            const char* a3 = a2 + kstep; const char* b3 = b2 + kstep;
            if (last && has_next) S.a_ready(nxt);
            if constexpr (SP2) {
            PG8_LDB(B0, 0, 0); PG8_LDB(B1, 0, 1); PG8_SCHED; PG8_LDA(At, 0, 0); PG8_STAGE(PG8_SA(1, 1), a1 + hstep, voffA);
            PG8_WAIT_V(8); PG8_WAIT_L(0); PG8_BAR; PG8_MMA(0, 0, At, B0); PG8_MMA(0, 1, At, B1); PG8_BAR; PG8_SCHED;
            PG8_LDA(At, 0, 1); PG8_STAGE(PG8_SB(0, 0), b2, voffB); PG8_STAGE(PG8_SB(0, 1), b2 + hstep, voffB); PG8_STAGE(PG8_SA(0, 0), a2, voffA);
            PG8_WAIT_V(8); PG8_WAIT_L(0); PG8_BAR; PG8_MMA(1, 0, At, B0); PG8_MMA(1, 1, At, B1); PG8_BAR; PG8_SCHED;
            PG8_LDB(B0, 1, 0); PG8_LDB(B1, 1, 1); PG8_SCHED; PG8_LDA(At, 1, 0); PG8_STAGE(PG8_SA(0, 1), a2 + hstep, voffA);
            PG8_WAIT_V(8); PG8_WAIT_L(0); PG8_BAR; PG8_MMA(0, 0, At, B0); PG8_MMA(0, 1, At, B1); PG8_BAR; PG8_SCHED;
            PG8_LDA(At, 1, 1); PG8_STAGE(PG8_SB(1, 0), b3, voffB); PG8_STAGE(PG8_SB(1, 1), b3 + hstep, voffB); PG8_STAGE(PG8_SA(1, 0), a3, voffA);
            PG8_WAIT_V(8); PG8_WAIT_L(0); PG8_BAR; PG8_MMA(1, 0, At, B0); PG8_MMA(1, 1, At, B1); PG8_BAR; PG8_SCHED;
            } else {
            PG8_LDB(B0, 0, 0); PG8_SCHED; PG8_LDA(At, 0, 0); PG8_STAGE(PG8_SA(1, 1), a1 + hstep, voffA);
            PG8_WAIT_L(8); PG8_BAR; PG8_WAIT_L(0); PG8_MMA(0, 0, At, B0); PG8_BAR; PG8_SCHED;
            PG8_LDB(B1, 0, 1); PG8_STAGE(PG8_SB(0, 0), b2, voffB);
            PG8_BAR; PG8_WAIT_L(0); PG8_MMA(0, 1, At, B1); PG8_BAR;
            PG8_LDA(At, 0, 1); PG8_STAGE(PG8_SA(0, 0), a2, voffA);
            PG8_BAR; PG8_WAIT_L(0); PG8_MMA(1, 0, At, B0); PG8_BAR; PG8_SCHED;
            PG8_STAGE(PG8_SB(0, 1), b2 + hstep, voffB);
            PG8_WAIT_V(6); PG8_BAR; PG8_MMA(1, 1, At, B1); PG8_BAR;
            PG8_LDB(B0, 1, 0); PG8_SCHED; PG8_LDA(At, 1, 0); PG8_STAGE(PG8_SA(0, 1), a2 + hstep, voffA);
            PG8_WAIT_L(8); PG8_BAR; PG8_WAIT_L(0); PG8_MMA(0, 0, At, B0); PG8_BAR; PG8_SCHED;
            PG8_LDB(B1, 1, 1); PG8_STAGE(PG8_SB(1, 0), b3, voffB);
            PG8_BAR; PG8_WAIT_L(0); PG8_MMA(0, 1, At, B1); PG8_BAR;
            PG8_LDA(At, 1, 1); PG8_STAGE(PG8_SA(1, 0), a3, voffA);
            PG8_BAR; PG8_WAIT_L(0); PG8_MMA(1, 0, At, B0); PG8_BAR; PG8_SCHED;
            PG8_STAGE(PG8_SB(1, 1), b3 + hstep, voffB);
            PG8_WAIT_V(6); PG8_BAR; PG8_MMA(1, 1, At, B1); PG8_BAR;
            }
        }
        if constexpr (ALIGN_EPI) { if (wr == 0) PG8_BAR; }
        if constexpr (!Epi::AFTER_DRAIN) { E(acc, cur, wr, wc, fr, fq); S.done(cur); }
        if (!has_next) break;
#pragma unroll
        for (int a = 0; a < 2; ++a)
#pragma unroll
            for (int b = 0; b < 2; ++b)
#pragma unroll
                for (int m = 0; m < 4; ++m)
#pragma unroll
                    for (int n = 0; n < 2; ++n) acc[a][b][m][n] = (f32x4){0.f, 0.f, 0.f, 0.f};
        cur = nxt; cA = nA; cB = nB; ++ui;
        if constexpr (ALIGN_EPI) { if (wr == 1) PG8_BAR; }
    }
    PG8_WAIT_V(0);
    if constexpr (!ALIGN_EPI) { if (wr == 0) PG8_BAR; }
    PG8_BAR;
    if constexpr (Epi::AFTER_DRAIN) { E.fused(acc, cur, wr, wc, fr, fq, lds, wid, lane); S.done(cur); }
#undef PG8_SA
#undef PG8_SB
#undef PG8_STAGE
#undef PG8_LDA
#undef PG8_LDB
#undef PG8_MMA
#undef PG8_WAIT_V
#undef PG8_WAIT_L
#undef PG8_BAR
#undef PG8_SCHED
}
}
namespace att {
typedef unsigned short bf16_t;
typedef short bf16x8 __attribute__((ext_vector_type(8)));
typedef short s16x4 __attribute__((ext_vector_type(4)));
typedef short v4i16_t __attribute__((ext_vector_type(4)));
typedef float f32x16 __attribute__((ext_vector_type(16)));
typedef unsigned u32x4 __attribute__((ext_vector_type(4)));
typedef float f32x2_t __attribute__((ext_vector_type(2))); typedef __bf16 bf16x2_t __attribute__((ext_vector_type(2)));
typedef __attribute__((address_space(3))) const char* lds_cptr;
#define MFMA32(a, b, c) __builtin_amdgcn_mfma_f32_32x32x16_bf16(a, b, c, 0, 0, 0)
__device__ __forceinline__ int crow(int r, int hi) { return (r & 3) + 8 * (r >> 2) + 4 * hi; }
__device__ __forceinline__ unsigned cvtpk(float lo, float hi) { f32x2_t v = {lo, hi}; bf16x2_t b = __builtin_convertvector(v, bf16x2_t); return __builtin_bit_cast(unsigned, b); }
__device__ __forceinline__ s16x4 vtr(lds_cptr p) { return __builtin_bit_cast(s16x4, __builtin_amdgcn_ds_read_tr16_b64_v4i16((__attribute__((address_space(3))) v4i16_t*)p)); }
__device__ __forceinline__ float bf2f(unsigned short b) { return __builtin_bit_cast(float, (unsigned)b << 16); }
__device__ __forceinline__ float lo2f(unsigned w) { return __builtin_bit_cast(float, w << 16); }
__device__ __forceinline__ float hi2f(unsigned w) { return __builtin_bit_cast(float, w & 0xffff0000u); }
#define MX3(a, b, c) __builtin_fmaxf(__builtin_fmaxf((a), (b)), (c))
__device__ __forceinline__ float rowmax(const f32x16& p0, const f32x16& p1) {
    float a = MX3(p0[0], p0[1], p1[0]), b = MX3(p0[2], p0[3], p1[1]); a = MX3(a, p1[2], p1[3]);
#pragma unroll
    for (int r = 4; r < 16; r += 4) { a = MX3(a, p0[r], p0[r + 1]); b = MX3(b, p0[r + 2], p0[r + 3]); a = MX3(a, p1[r], p1[r + 1]); b = MX3(b, p1[r + 2], p1[r + 3]); }
    float m = __builtin_fmaxf(a, b); auto rr = __builtin_amdgcn_permlane32_swap(__float_as_uint(m), __float_as_uint(m), false, false);
    return __builtin_fmaxf(__uint_as_float(rr[0]), __uint_as_float(rr[1])); }
constexpr int LDS_K = 0, LDS_V = 16384, LDS_S1 = 0, LDS_STG = 65536, LDS_WS = 98304, LDS_BYTES = 98304 + 2048;

__device__ __forceinline__ void attn_unit(int b, int h, int qb, const bf16_t* Q, const bf16_t* K, const bf16_t* V, const bf16_t* SZB, bf16_t* Y, const float* subg, float lam, char* shm) {
    const int tid = threadIdx.x, lane = tid & 63, r32 = lane & 31, hi = lane >> 5; const int wid = __builtin_amdgcn_readfirstlane(tid >> 6);
    const int t = wid >> 2, wq = wid & 3, hh = 2 * h + t;
    const long rowbase = (long)b * SEQ; const int q0 = qb * 128;
    const bf16_t* Qw = Q + (rowbase + q0 + wq * 32 + r32) * 512 + hh * 64 + hi * 8;
    bf16x8 qr[4];
#pragma unroll
    for (int d0 = 0; d0 < 4; ++d0) qr[d0] = *reinterpret_cast<const bf16x8*>(Qw + d0 * 16);
    f32x16 o[4];
#pragma unroll
    for (int d0 = 0; d0 < 4; ++d0) o[d0] = f32x16{};
    float mrun = -1e30f, l = 0.f;
    float* wsf = (float*)(shm + LDS_WS) + wid * 64;
    const int NT = 2 * qb + 2, myNT = 2 * qb + 1 + (wq >> 1);
    const lds_cptr shm3 = (lds_cptr)shm;
    const lds_cptr kp0 = shm3 + LDS_K + t * 8192 + hi * 1024 + r32 * 16;
    const lds_cptr vp0 = shm3 + LDS_V + ((lane >> 4) & 1) * 32 + (lane & 3) * 8 + (4 * hi + ((lane & 15) >> 2)) * 64;
    for (int tile = 0; tile < NT; ++tile) {
        __syncthreads();
        { const long key0 = rowbase + (long)tile * 64;
          const bf16_t* ks = K + (key0 + lane) * 512 + (2 * h) * 64 + wid * 8;
          const u32x4 k0v = *(const u32x4*)ks, k1v = *(const u32x4*)(ks + 64);
          *(u32x4*)(shm + LDS_K + wid * 1024 + lane * 16) = k0v; *(u32x4*)(shm + LDS_K + 8192 + wid * 1024 + lane * 16) = k1v;
#pragma unroll
          for (int i = 0; i < 2; ++i) { const int wp = wid + 8 * i;
              const bf16_t* vs = V + (key0 + 16 * (wp & 3) + (lane >> 2)) * 512 + h * 128 + (wp >> 2) * 32 + (lane & 3) * 8;
              *(u32x4*)(shm + LDS_V + wp * 1024 + lane * 16) = *(const u32x4*)vs; } }
        __syncthreads();
        if (tile < myNT) {
            f32x16 p0 = f32x16{}, p1 = f32x16{};
#pragma unroll
            for (int d0 = 0; d0 < 4; ++d0) {
                const bf16x8 b0 = *(const __attribute__((address_space(3))) bf16x8*)(kp0 + d0 * 2048);
                const bf16x8 b1 = *(const __attribute__((address_space(3))) bf16x8*)(kp0 + d0 * 2048 + 512);
                p0 = MFMA32(b0, qr[d0], p0); p1 = MFMA32(b1, qr[d0], p1); }
            const float rm = rowmax(p0, p1);
            const float mn = __builtin_fmaxf(mrun, rm);
            const float alpha = __builtin_amdgcn_exp2f(mrun - mn); mrun = mn;
            float sum = 0.f;
#pragma unroll
            for (int r = 0; r < 16; ++r) { p0[r] = __builtin_amdgcn_exp2f(p0[r] - mn); p1[r] = __builtin_amdgcn_exp2f(p1[r] - mn); sum += p0[r] + p1[r]; }
            l = l * alpha + sum;
            if (__any(alpha != 1.0f)) {
                if (hi == 0) wsf[r32] = alpha;
                asm volatile("s_waitcnt lgkmcnt(0)" ::: "memory");
#pragma unroll
                for (int r = 0; r < 16; ++r) { const float a = wsf[crow(r, hi)];
#pragma unroll
                    for (int d0 = 0; d0 < 4; ++d0) o[d0][r] *= a; }
            }
            u32x4 pw[4];
#pragma unroll
            for (int i = 0; i < 4; ++i) { pw[0][i] = cvtpk(p0[2 * i], p0[2 * i + 1]); pw[1][i] = cvtpk(p0[8 + 2 * i], p0[9 + 2 * i]); pw[2][i] = cvtpk(p1[2 * i], p1[2 * i + 1]); pw[3][i] = cvtpk(p1[8 + 2 * i], p1[9 + 2 * i]); }
#pragma unroll
            for (int d0 = 0; d0 < 4; ++d0)
#pragma unroll
                for (int ks = 0; ks < 4; ++ks) {
                    const s16x4 vl = vtr(vp0 + d0 * 4096 + ks * 1024), vh = vtr(vp0 + d0 * 4096 + ks * 1024 + 512);
                    const bf16x8 vf = (bf16x8){vl[0], vl[1], vl[2], vl[3], vh[0], vh[1], vh[2], vh[3]};
                    o[d0] = MFMA32(__builtin_bit_cast(bf16x8, pw[ks]), vf, o[d0]); }
        }
    }
    { auto rr = __builtin_amdgcn_permlane32_swap(__float_as_uint(l), __float_as_uint(l), false, false); l = __uint_as_float(rr[0]) + __uint_as_float(rr[1]); }
    if (hi == 0) wsf[32 + r32] = l;
    asm volatile("s_waitcnt lgkmcnt(0)" ::: "memory");
    float rli[16];
#pragma unroll
    for (int r = 0; r < 16; ++r) rli[r] = 1.0f / wsf[32 + crow(r, hi)];
    __syncthreads();
    float* S1 = (float*)(shm + LDS_S1);
    if (t == 1) {
#pragma unroll
        for (int d0 = 0; d0 < 4; ++d0)
#pragma unroll
            for (int r = 0; r < 16; ++r) S1[(wq * 32 + crow(r, hi)) * 128 + d0 * 32 + r32] = lam * o[d0][r] * rli[r];
    }
    __syncthreads();
    if (t == 0) {
        float rinv[16];
#pragma unroll
        for (int r = 0; r < 16; ++r) { float ss = 0.f;
#pragma unroll
            for (int d0 = 0; d0 < 4; ++d0) { const float d = o[d0][r] * rli[r] - S1[(wq * 32 + crow(r, hi)) * 128 + d0 * 32 + r32]; o[d0][r] = d; ss += d * d; }
            ss += __shfl_xor(ss, 1); ss += __shfl_xor(ss, 2); ss += __shfl_xor(ss, 4); ss += __shfl_xor(ss, 8); ss += __shfl_xor(ss, 16);
            rinv[r] = 1.0f / sqrtf(ss * (1.0f / 128.0f) + EPS); }
        bf16_t* stg = (bf16_t*)(shm + LDS_STG) + wq * 4096;
#pragma unroll
        for (int d0 = 0; d0 < 4; ++d0) { const float gsc = subg[d0 * 32 + r32] * (1.0f - LAM_INIT);
#pragma unroll
            for (int r = 0; r < 16; ++r) { const unsigned w = cvtpk(o[d0][r] * rinv[r] * gsc, 0.f); stg[crow(r, hi) * 128 + d0 * 32 + r32] = (bf16_t)(w & 0xffffu); } }
        asm volatile("s_waitcnt lgkmcnt(0)" ::: "memory");
#pragma unroll
        for (int i = 0; i < 8; ++i) { const int row = i * 4 + (lane >> 4), ch = lane & 15;
            const u32x4 sv = *(const u32x4*)(stg + row * 128 + ch * 8);
            const long grow = rowbase + q0 + wq * 32 + row;
            const u32x4 zv = *(const u32x4*)(SZB + grow * 512 + h * 128 + ch * 8);
            u32x4 ov;
#pragma unroll
            for (int e = 0; e < 4; ++e) ov[e] = cvtpk(lo2f(sv[e]) * lo2f(zv[e]), hi2f(sv[e]) * hi2f(zv[e]));
            *(u32x4*)(Y + grow * 1024 + 512 + h * 128 + ch * 8) = ov; }
    }
    __syncthreads();
}

__device__ __forceinline__ void gmlp_unit(int win, int g, const bf16_t* GU, const bf16_t* GV, const bf16_t* SZA, const bf16_t* WSM, const float* lng, const float* lnb, const float* bs, bf16_t* Y, char* shm) {
    const int tid = threadIdx.x, lane = tid & 63, r32 = lane & 31, hi = lane >> 5; const int wid = __builtin_amdgcn_readfirstlane(tid >> 6);
    const long row0 = (long)win * 128;
#pragma unroll
    for (int i = 0; i < 4; ++i) {
        const int piece = tid + 512 * i, j = piece >> 4, ch = piece & 15;
        const u32x4 raw = *(const u32x4*)(GV + (row0 + j) * 512 + g * 128 + ch * 8);
        float x[8];
#pragma unroll
        for (int e = 0; e < 4; ++e) { x[2 * e] = lo2f(raw[e]); x[2 * e + 1] = hi2f(raw[e]); }
        float s = 0.f;
#pragma unroll
        for (int e = 0; e < 8; ++e) s += x[e];
        s += __shfl_xor(s, 1); s += __shfl_xor(s, 2); s += __shfl_xor(s, 4); s += __shfl_xor(s, 8);
        const float mean = s * (1.0f / 128.0f); float q = 0.f;
#pragma unroll
        for (int e = 0; e < 8; ++e) { x[e] -= mean; q += x[e] * x[e]; }
        q += __shfl_xor(q, 1); q += __shfl_xor(q, 2); q += __shfl_xor(q, 4); q += __shfl_xor(q, 8);
        const float rstd = 1.0f / sqrtf(q * (1.0f / 128.0f) + EPS);
        const float4 g0 = *(const float4*)(lng + g * 128 + ch * 8), g1 = *(const float4*)(lng + g * 128 + ch * 8 + 4);
        const float4 b0 = *(const float4*)(lnb + g * 128 + ch * 8), b1 = *(const float4*)(lnb + g * 128 + ch * 8 + 4);
        u32x4 w;
        w[0] = cvtpk(x[0] * rstd * g0.x + b0.x, x[1] * rstd * g0.y + b0.y); w[1] = cvtpk(x[2] * rstd * g0.z + b0.z, x[3] * rstd * g0.w + b0.w);
        w[2] = cvtpk(x[4] * rstd * g1.x + b1.x, x[5] * rstd * g1.y + b1.y); w[3] = cvtpk(x[6] * rstd * g1.z + b1.z, x[7] * rstd * g1.w + b1.w);
        *(u32x4*)(shm + (ch >> 2) * 8192 + j * 64 + (ch & 3) * 16) = w;
    }
    __syncthreads();
    const int ib = wid >> 1, cbh = wid & 1, ksteps = (ib < 2) ? 4 : 8;
    f32x16 acc[2]; acc[0] = f32x16{}; acc[1] = f32x16{};
    const lds_cptr vb = (lds_cptr)shm + (8 * hi + ((lane & 15) >> 2)) * 64 + ((lane >> 4) & 1) * 32 + (lane & 3) * 8;
    const bf16_t* wrow = WSM + ((size_t)g * 128 + ib * 32 + r32) * 128 + hi * 8;
    for (int s = 0; s < ksteps; ++s) {
        const bf16x8 a = *(const bf16x8*)(wrow + s * 16);
#pragma unroll
        for (int cc = 0; cc < 2; ++cc) { const int cb = 2 * cbh + cc;
            const s16x4 vl = vtr(vb + cb * 8192 + s * 1024), vh = vtr(vb + cb * 8192 + s * 1024 + 256);
            const bf16x8 vf = (bf16x8){vl[0], vl[1], vl[2], vl[3], vh[0], vh[1], vh[2], vh[3]};
            acc[cc] = MFMA32(a, vf, acc[cc]); }
    }
#pragma unroll
    for (int cc = 0; cc < 2; ++cc) { const int c = (2 * cbh + cc) * 32 + r32;
#pragma unroll
        for (int r = 0; r < 16; ++r) { const int i = ib * 32 + crow(r, hi); const long row = row0 + i;
            const float sv = acc[cc][r] + bs[g * 128 + i];
            const float u = bf2f(GU[row * 512 + g * 128 + c]), z = bf2f(SZA[row * 512 + g * 128 + c]);
            const unsigned w = cvtpk(u * sv * z, 0.f); Y[row * 1024 + g * 128 + c] = (bf16_t)(w & 0xffffu); } }
    __syncthreads();
}
#undef MX3
}


constexpr int NWAVES = 8;
constexpr int N_LAUNCHES = MK_N_LAUNCHES;
constexpr int PER_PHASE = 6;
constexpr size_t MiB = 1u << 20;
constexpr size_t WS_CTL = 0, CTL_ZERO_BYTES = 1 * MiB;
constexpr size_t WS_MOD = 1 * MiB;
constexpr size_t WS_CS = 2 * MiB;
constexpr size_t WS_WIN = 6 * MiB;
constexpr size_t WS_WOUT = 13 * MiB;
constexpr size_t WS_WSM = 15 * MiB;
constexpr size_t WS_H = 16 * MiB;
constexpr size_t WS_PROJ = 48 * MiB;
constexpr size_t WS_Y = 160 * MiB;
constexpr size_t WS_END = 192 * MiB;
constexpr int CW_BAR = 4096;
constexpr int RING_OFF = 0, RING_BYTES = 131072;
constexpr int LDSCTL_OFF = RING_BYTES, MISC_OFF = LDSCTL_OFF + 320;
constexpr int LDS_BYTES = 147456;

#define GAS __attribute__((address_space(1)))
#define LAS __attribute__((address_space(3)))
typedef unsigned short bf16;
typedef unsigned v4u __attribute__((ext_vector_type(4)));
typedef float f32x4 __attribute__((ext_vector_type(4)));
typedef short bf16x8 __attribute__((ext_vector_type(8)));
typedef GAS unsigned gu32;
typedef GAS unsigned long long gu64;
#define RLX_AGENT __ATOMIC_RELAXED, __HIP_MEMORY_SCOPE_AGENT
#define LDS_WAIT() asm volatile("s_waitcnt lgkmcnt(0)" ::: "memory")
#define VM_WAIT() asm volatile("s_waitcnt vmcnt(0)" ::: "memory")
__device__ __forceinline__ unsigned long long rt() { return __builtin_amdgcn_s_memrealtime(); }
__device__ __forceinline__ unsigned f2bf(float f) { unsigned u = __builtin_bit_cast(unsigned, f); return (u + 0x7fffu + ((u >> 16) & 1u)) >> 16; }
__device__ __forceinline__ unsigned pk2(float lo, float hi) { return f2bf(lo) | (f2bf(hi) << 16); }

#define XB_TMO      128
#define XB_XCNT(j)  (256  + 64 * (j))
#define XB_XSUB(j)  (1280 + 64 * (j))
#define XB_XGEN(j)  (2304 + 64 * (j))
#define XB_TOP      3328
#define XB_TOPGEN   3392
#define XCD_BAR_WORDS 3456
#define XB_SPIN_CAP (1u << 18)

__device__ __forceinline__ unsigned xb_ld(unsigned* p)              { return __hip_atomic_load(p, __ATOMIC_RELAXED, __HIP_MEMORY_SCOPE_AGENT); }
__device__ __forceinline__ unsigned xb_add(unsigned* p, unsigned v) { return __hip_atomic_fetch_add(p, v, __ATOMIC_RELAXED, __HIP_MEMORY_SCOPE_AGENT); }
__device__ __forceinline__ unsigned xb_xcc_id() { return (unsigned)__builtin_amdgcn_s_getreg((3 << 11) | 20) & 0xFu; }
#define XB_SPIN(cond, bar) do { unsigned _sp = 0; while (cond) { __builtin_amdgcn_s_sleep(1); \
    if ((++_sp & 255u) == 0u) { if (xb_ld(&(bar)[XB_TMO])) break; if (_sp > XB_SPIN_CAP) { atomicAdd(&(bar)[XB_TMO], 1u); break; } } } } while (0)

struct XcdBarrier {
    unsigned* bar; unsigned x;
    volatile LAS unsigned* st;
};

__device__ __forceinline__ XcdBarrier xcd_barrier_post(unsigned* bar, volatile LAS unsigned* st) {
    XcdBarrier b; b.bar = bar; b.x = xb_xcc_id(); b.st = st;
    if (threadIdx.x == 0) (void)xb_add(&bar[XB_XCNT(b.x)], 1u);
    return b;
}
__device__ __forceinline__ void xcd_barrier_complete(unsigned* bar, unsigned x, unsigned& nloc, unsigned& nx) {
    const unsigned G = gridDim.x * gridDim.y * gridDim.z;
    unsigned sum, cnt, mine, sp = 0u;
    for (;;) {
        sum = 0u; cnt = 0u; mine = 0u;
#pragma unroll
        for (unsigned j = 0; j < 16; ++j) { const unsigned c = xb_ld(&bar[XB_XCNT(j)]); sum += c; cnt += (c > 0u) ? 1u : 0u; mine = (j == x) ? c : mine; }
        if (sum == G) break;
        __builtin_amdgcn_s_sleep(1);
        if ((++sp & 255u) == 0u) { if (xb_ld(&bar[XB_TMO])) break; if (sp > XB_SPIN_CAP) { atomicAdd(&bar[XB_TMO], 1u); break; } }
    }
    nloc = mine > 0u ? mine : 1u; nx = cnt > 0u ? cnt : 1u;
}

__device__ __forceinline__ void xcd_barrier(const XcdBarrier& b) {
    asm volatile("s_waitcnt vmcnt(0)" ::: "memory");
    __syncthreads();
    if (threadIdx.x == 0) {
        unsigned* bar = b.bar;
        __builtin_amdgcn_s_waitcnt(0);
        unsigned nloc = b.st[0], nx = b.st[1];
        if (nloc == 0u) { xcd_barrier_complete(bar, b.x, nloc, nx); b.st[0] = nloc; b.st[1] = nx; }
        const unsigned old = xb_add(&bar[XB_XSUB(b.x)], 1u);
        const unsigned gen = old / nloc;
        if (old + 1u == (gen + 1u) * nloc) {
            __builtin_amdgcn_fence(__ATOMIC_RELEASE, "agent");
            asm volatile("s_waitcnt vmcnt(0)" ::: "memory");
            const unsigned og = xb_add(&bar[XB_TOP], 1u);
            const unsigned tg = og / nx;
            if (og + 1u == (tg + 1u) * nx) xb_add(&bar[XB_TOPGEN], 1u);
            else XB_SPIN(xb_ld(&bar[XB_TOPGEN]) == tg, bar);
            __builtin_amdgcn_fence(__ATOMIC_ACQUIRE, "agent");
            xb_add(&bar[XB_XGEN(b.x)], 1u);
            asm volatile("s_waitcnt vmcnt(0)" ::: "memory");
        } else {
            XB_SPIN(xb_ld(&bar[XB_XGEN(b.x)]) == gen, bar);
            __builtin_amdgcn_fence(__ATOMIC_ACQUIRE, "agent");
            asm volatile("s_waitcnt vmcnt(0)" ::: "memory");
        }
    }
    __syncthreads();
}

__device__ const double INV_REV[32] = {0.15915494309189535, 0.11934937021124886, 0.08949940160889101, 0.06711508300522726, 0.050329212104487035, 0.03774158471741977, 0.0283021958306234, 0.02122365276477766, 0.015915494309189534, 0.011934937021124886, 0.008949940160889102, 0.006711508300522725, 0.005032921210448704, 0.003774158471741977, 0.00283021958306234, 0.0021223652764777662, 0.0015915494309189536, 0.0011934937021124885, 0.0008949940160889102, 0.0006711508300522726, 0.0005032921210448703, 0.00037741584717419774, 0.00028302195830623395, 0.0002122365276477766, 0.00015915494309189535, 0.00011934937021124886, 8.949940160889102e-05, 6.711508300522725e-05, 5.0329212104487035e-05, 3.774158471741978e-05, 2.8302195830623396e-05, 2.122365276477766e-05};

struct Frame {
    LAS unsigned char* lds;
    volatile LAS unsigned* MISC;
    gu32* ctl;
    int tid, lane, wave;
    int vcu, G;
};
__device__ __forceinline__ float wave_sum(float v) {
#pragma unroll
    for (int o = 1; o < 64; o <<= 1) v += __shfl_xor(v, o);
    return v;
}
__device__ __forceinline__ int sigma_col(int n) {
    if (n < 1536 || n >= 2560) return n;
    const int p = n & 63, g = p >> 3, i = p & 7; return (n & ~63) + 4 * g + (i & 3) + 32 * (i >> 2);
}
template <bool SIG>
__device__ __forceinline__ void p0_transpose_item(const float* W, int K, int N, bf16* WT, LAS float* scr, int item, int lane) {
    const int nblk = N / 32, kb = item / nblk, nb = item % nblk, k0 = 64 * kb, n0 = 32 * nb;
    const int scol = SIG ? sigma_col(n0 + (lane & 31)) : n0 + (lane & 31);
#pragma unroll 8
    for (int i = 0; i < 32; ++i) { const int kk = 2 * i + (lane >> 5); scr[kk * 33 + (lane & 31)] = W[(size_t)(k0 + kk) * N + scol]; }
    LDS_WAIT(); asm volatile("" ::: "memory");
    const int c = lane & 7;
#pragma unroll
    for (int j = 0; j < 4; ++j) { const int n = (lane >> 3) + 8 * j; const LAS float* s = scr + (8 * c) * 33 + n;
        v4u o; o.x = pk2(s[0 * 33], s[1 * 33]); o.y = pk2(s[2 * 33], s[3 * 33]); o.z = pk2(s[4 * 33], s[5 * 33]); o.w = pk2(s[6 * 33], s[7 * 33]);
        *(GAS v4u*)(WT + (size_t)(n0 + n) * K + k0 + 8 * c) = o; }
    LDS_WAIT(); asm volatile("" ::: "memory");
}
constexpr int NGEMV_WG = 48;
struct Ptrs {
    const float *x, *c, *w_ada, *b_ada, *norm_g, *w_in, *ln_g, *ln_b, *gws, *gbs, *lq1, *lk1, *lq2, *lk2, *subg, *w_out, *fin_g; const int* pos;
    float* out; float* mod; float* cs; bf16 *win_t, *wout_t, *wsm, *H, *proj, *Y;
};
__device__ __forceinline__ void p0_prologue(Frame& F, const Ptrs& P) {
    { const int gt = F.vcu * (NWAVES * 64) + F.tid, NT = F.G * NWAVES * 64;
      for (int idx = gt; idx < M * 32; idx += NT) { const int m = idx >> 5, d = idx & 31;
          const double rev = (double)P.pos[m] * INV_REV[d]; const double fr = rev - __builtin_rint(rev); const float ang = (float)(fr * 6.283185307179586476925);
          float sn, cn; sn = sinf(ang); cn = cosf(ang);
          P.cs[(size_t)m * 64 + (d >> 2) * 8 + (d & 3)] = cn; P.cs[(size_t)m * 64 + (d >> 2) * 8 + 4 + (d & 3)] = sn; }
      for (int e = gt; e < 4 * 128 * 128; e += NT) { const int i = (e >> 7) & 127, j = e & 127; P.wsm[e] = (bf16)(((i >> 6) >= (j >> 6)) ? f2bf(P.gws[e]) : 0u); } }
    if (F.vcu < NGEMV_WG) {
        LAS float* csl = (LAS float*)(F.lds + RING_OFF);
        LAS float* red = csl + 2048;
        for (int i = F.tid; i < 2048; i += NWAVES * 64) { const float v = P.c[i]; csl[i] = v / (1.0f + __expf(-v)); }
        __syncthreads();
        const int n = F.vcu * 64 + F.lane, kb = F.wave * 128; float a0 = 0.f, a1 = 0.f;
#pragma unroll 16
        for (int k = 0; k < 128; ++k) { const float w = P.w_ada[(size_t)(kb + k) * 3072 + n]; a0 += csl[kb + k] * w; a1 += csl[1024 + kb + k] * w; }
        red[(F.wave * 2 + 0) * 64 + F.lane] = a0; red[(F.wave * 2 + 1) * 64 + F.lane] = a1;
        __syncthreads();
        if (F.tid < 128) { const int b = F.tid >> 6, l = F.tid & 63; float s = P.b_ada[F.vcu * 64 + l];
#pragma unroll
            for (int w = 0; w < 8; ++w) s += red[(w * 2 + b) * 64 + l];
            P.mod[b * 3072 + F.vcu * 64 + l] = s; }
        __syncthreads();
    } else {
        LAS float* scr = (LAS float*)(F.lds + RING_OFF + F.wave * 16384);
        const int gw = (F.vcu - NGEMV_WG) * NWAVES + F.wave, NGW = (F.G - NGEMV_WG) * NWAVES;
        constexpr int I_IN = (DM / 64) * (DIN / 32), I_OUT = (DM / 64) * (DM / 32);
        for (int it = gw; it < I_IN + I_OUT; it += NGW) {
            if (it < I_IN) p0_transpose_item<true>(P.w_in, DM, DIN, P.win_t, scr, it, F.lane);
            else p0_transpose_item<false>(P.w_out, DM, DM, P.wout_t, scr, it - I_IN, F.lane);
        }
    }
}
__device__ __forceinline__ void p1_hrows(Frame& F, const Ptrs& P) {
    const int gw = F.vcu * NWAVES + F.wave, NGW = F.G * NWAVES;
    for (int blk = gw; blk < M / 8; blk += NGW) {
        const int b = (blk * 8) / SEQ; const float* shift = P.mod + b * 3072; const float* scale = shift + 1024;
        f32x4 gs[4], sh[4];
#pragma unroll
        for (int j = 0; j < 4; ++j) { const f32x4 g = *(const f32x4*)(P.norm_g + 4 * F.lane + 256 * j), sc = *(const f32x4*)(scale + 4 * F.lane + 256 * j); gs[j] = g * (sc + 1.0f); sh[j] = *(const f32x4*)(shift + 4 * F.lane + 256 * j); }
        for (int rr = 0; rr < 8; ++rr) {
            const size_t m = (size_t)blk * 8 + rr;
            const GAS f32x4* xr = (const GAS f32x4*)(P.x + m * DM) + F.lane;
            f32x4 v[4]; float s = 0.f;
#pragma unroll
            for (int j = 0; j < 4; ++j) { v[j] = xr[64 * j]; s += (v[j].x * v[j].x + v[j].y * v[j].y) + (v[j].z * v[j].z + v[j].w * v[j].w); }
            const float rinv = 1.0f / sqrtf(wave_sum(s) * (1.0f / DM) + EPS);
            GAS unsigned long long* o8 = (GAS unsigned long long*)(P.H + m * DM) + F.lane;
#pragma unroll
            for (int j = 0; j < 4; ++j) { const f32x4 y = v[j] * rinv * gs[j] + sh[j]; o8[64 * j] = (unsigned long long)pk2(y.x, y.y) | ((unsigned long long)pk2(y.z, y.w) << 32); }
        }
    }
}
__device__ __forceinline__ void p5_final(Frame& F, const Ptrs& P) {
    const int gw = F.vcu * NWAVES + F.wave, NGW = F.G * NWAVES;
    f32x4 fg[4];
#pragma unroll
    for (int j = 0; j < 4; ++j) fg[j] = *(const f32x4*)(P.fin_g + 4 * F.lane + 256 * j);
    for (int m = gw; m < M; m += NGW) {
        GAS f32x4* xr = (GAS f32x4*)(P.out + (size_t)m * DM) + F.lane;
        f32x4 v[4]; float s = 0.f;
#pragma unroll
        for (int j = 0; j < 4; ++j) { v[j] = xr[64 * j]; s += (v[j].x * v[j].x + v[j].y * v[j].y) + (v[j].z * v[j].z + v[j].w * v[j].w); }
        const float rinv = 1.0f / sqrtf(wave_sum(s) * (1.0f / DM) + EPS);
#pragma unroll
        for (int j = 0; j < 4; ++j) xr[64 * j] = v[j] * rinv * fg[j];
    }
}

struct Args { const void* in[18]; float* out; unsigned char* ws; int ph_lo, ph_hi, li, pad; };
__global__ void __launch_bounds__(NWAVES * 64, 2) blk_fwd(Args args) {
    extern __shared__ __attribute__((aligned(16))) unsigned char lds[];
    Frame F;
    F.lds = (LAS unsigned char*)lds;
    F.MISC = (volatile LAS unsigned*)(F.lds + MISC_OFF);
    F.tid = threadIdx.x; F.lane = F.tid & 63; F.wave = __builtin_amdgcn_readfirstlane(F.tid >> 6);
    F.G = gridDim.x; { const int bx = blockIdx.x; F.vcu = (F.G % 8 == 0) ? (bx % 8) * (F.G / 8) + bx / 8 : bx; }
    unsigned char* ws = args.ws;
    F.ctl = (gu32*)(ws + WS_CTL);
    Ptrs P;
    P.x = (const float*)args.in[0]; P.c = (const float*)args.in[1]; P.pos = (const int*)args.in[2]; P.w_ada = (const float*)args.in[3]; P.b_ada = (const float*)args.in[4];
    P.norm_g = (const float*)args.in[5]; P.w_in = (const float*)args.in[6]; P.ln_g = (const float*)args.in[7]; P.ln_b = (const float*)args.in[8]; P.gws = (const float*)args.in[9];
    P.gbs = (const float*)args.in[10]; P.lq1 = (const float*)args.in[11]; P.lk1 = (const float*)args.in[12]; P.lq2 = (const float*)args.in[13]; P.lk2 = (const float*)args.in[14];
    P.subg = (const float*)args.in[15]; P.w_out = (const float*)args.in[16]; P.fin_g = (const float*)args.in[17];
    P.out = args.out; P.mod = (float*)(ws + WS_MOD); P.cs = (float*)(ws + WS_CS); P.win_t = (bf16*)(ws + WS_WIN); P.wout_t = (bf16*)(ws + WS_WOUT); P.wsm = (bf16*)(ws + WS_WSM);
    P.H = (bf16*)(ws + WS_H); P.proj = (bf16*)(ws + WS_PROJ); P.Y = (bf16*)(ws + WS_Y);
    for (int u = F.tid; u < (LDS_BYTES - LDSCTL_OFF) / 4; u += NWAVES * 64) ((LAS unsigned*)(F.lds + LDSCTL_OFF))[u] = 0u;
    __syncthreads();
    XcdBarrier bar; bar.bar = (unsigned*)(F.ctl + CW_BAR); bar.x = 0; bar.st = nullptr;
    if (N_LAUNCHES != PER_PHASE) bar = xcd_barrier_post((unsigned*)(F.ctl + CW_BAR), F.MISC + 8);
#define GRID_BAR() do { if (N_LAUNCHES != PER_PHASE) xcd_barrier(bar); } while (0)
    const int lo = args.ph_lo, hi = args.ph_hi;
#define IN(k) (lo <= (k) && (k) < hi)
#define BOTH(k) (IN(k) && IN((k) + 1))

    if (IN(0)) { p0_prologue(F, P); if (BOTH(0)) GRID_BAR(); }
    if (IN(1)) { p1_hrows(F, P); if (BOTH(1)) GRID_BAR(); }
    if (IN(2)) {
        pg8::Gemm g{P.H, P.win_t, M, DIN, DM}; pg8::StaticOrder S; S.init(M, DIN, F.G, (int)blockIdx.x);
        pg8::EpiProj E{P.proj, P.cs};
        pg8::gemm_phase<pg8::EpiProj, pg8::StaticOrder, true, true>(F.lds + RING_OFF, g, S, E);
        if (BOTH(2)) GRID_BAR();
    }
    if (IN(3)) {
        float lam; { float s1 = 0.f, s2 = 0.f;
            for (int d = 0; d < HD; ++d) { s1 += P.lq1[d] * P.lk1[d]; s2 += P.lq2[d] * P.lk2[d]; } lam = __expf(s1) - __expf(s2) + LAM_INIT; }
        const bf16* Qb = P.proj + 3 * BUF_STRIDE; const bf16* Kb = P.proj + 4 * BUF_STRIDE; const bf16* Vb = P.proj + 5 * BUF_STRIDE; const bf16* SZB = P.proj + 6 * BUF_STRIDE;
        for (int v = F.vcu; v < 256; v += F.G) {
            const int bh = v >> 5, s = v & 31;
            att::attn_unit(bh >> 2, bh & 3, s, Qb, Kb, Vb, SZB, P.Y, P.subg, lam, (char*)lds + RING_OFF);
            att::attn_unit(bh >> 2, bh & 3, 63 - s, Qb, Kb, Vb, SZB, P.Y, P.subg, lam, (char*)lds + RING_OFF);
        }
        for (int it = F.vcu; it < 512; it += F.G)
            att::gmlp_unit(it >> 2, it & 3, P.proj, P.proj + BUF_STRIDE, P.proj + 2 * BUF_STRIDE, P.wsm, P.ln_g, P.ln_b, P.gbs, P.Y, (char*)lds + RING_OFF);
        if (BOTH(3)) GRID_BAR();
    }
    if (IN(4)) {
        pg8::Gemm g{P.Y, P.wout_t, M, DM, DM}; pg8::StaticOrder S; S.init(M, DM, F.G, (int)blockIdx.x);
        pg8::EpiOut E{P.x, P.out, P.mod + 2 * DM};
        pg8::gemm_phase<pg8::EpiOut, pg8::StaticOrder, true, true>(F.lds + RING_OFF, g, S, E);
        if (BOTH(4)) GRID_BAR();
    }
    if (IN(5)) { p5_final(F, P); }
#undef IN
#undef BOTH
}

extern "C" void kernel_launch(void* const* d_in, const int* in_sizes, int n_in, void* d_out, int out_size, void* d_ws, size_t ws_size, hipStream_t stream) {
    static int grid = 0;
    if (grid == 0) {
        if (n_in != 18 || out_size != M * DM || ws_size < WS_END) { fprintf(stderr, "kernel_launch: unexpected shapes (n_in %d, out %d, ws %zu)\n", n_in, out_size, ws_size); grid = -1; return; }
        int dev = 0, cus = 0, per_cu = 0;
        if (hipGetDevice(&dev) != hipSuccess || hipDeviceGetAttribute(&cus, hipDeviceAttributeMultiprocessorCount, dev) != hipSuccess) { grid = -1; return; }
        if (hipFuncSetAttribute((const void*)blk_fwd, hipFuncAttributeMaxDynamicSharedMemorySize, LDS_BYTES) != hipSuccess) { fprintf(stderr, "kernel_launch: hipFuncSetAttribute failed\n"); grid = -1; return; }
        if (hipOccupancyMaxActiveBlocksPerMultiprocessor(&per_cu, (const void*)blk_fwd, NWAVES * 64, LDS_BYTES) != hipSuccess || per_cu < 1)
            fprintf(stderr, "kernel_launch: note: occupancy query reports %d workgroups per CU\n", per_cu);
        (void)hipGetLastError();
        grid = cus;
        if (grid > 256) grid = 256;
    }
    if (grid < 0) return;
    if (hipMemsetAsync((char*)d_ws + WS_CTL, 0, CTL_ZERO_BYTES, stream) != hipSuccess) { fprintf(stderr, "kernel_launch: memset failed\n"); return; }
    Args a{};
    for (int i = 0; i < 18; ++i) a.in[i] = d_in[i];
    a.out = (float*)d_out; a.ws = (unsigned char*)d_ws;
    for (int li = 0; li < N_LAUNCHES; ++li) {
        a.ph_lo = (N_LAUNCHES == PER_PHASE) ? li : 0; a.ph_hi = (N_LAUNCHES == PER_PHASE) ? li + 1 : PER_PHASE; a.li = li;
        hipLaunchKernelGGL(blk_fwd, dim3(grid), dim3(NWAVES * 64), LDS_BYTES, stream, a);
        const hipError_t le = hipPeekAtLastError();
        if (le != hipSuccess) { fprintf(stderr, "kernel_launch: launch %d failed: %s\n", li, hipGetErrorName(le)); break; }
    }
}
```

```cpp
#include <hip/hip_runtime.h>
#include <cstdio>
#include <cstdint>
#ifndef MK_N_LAUNCHES
#define MK_N_LAUNCHES 1
#endif
constexpr int BATCH = 2, SEQ = 8192, DM = 1024, M = BATCH * SEQ;
constexpr int DG = 512, DD = 512, DIN = 3584, NBUF = 7;
constexpr int NH = 4, HD = 64, VD = 128;
constexpr float EPS = 1e-6f, LAM_INIT = 0.2f;
constexpr float QSCALE = 0.125f * 1.4426950408889634f;
constexpr size_t BUF_STRIDE = (size_t)M * 512;
namespace pg8 {
#define PG8_LAS __attribute__((address_space(3)))
typedef unsigned short bf16_t;
typedef short bf16x8 __attribute__((ext_vector_type(8)));
typedef float f32x4 __attribute__((ext_vector_type(4)));
typedef unsigned u32x4 __attribute__((ext_vector_type(4)));
constexpr int BM = 256, BK = 64, HALF = 128, HTB = HALF * BK * 2  , STAGE_BYTES = 8 * HTB, NXCD = 8, WGM = 8;

__host__ __device__ __forceinline__ int lds_byte(int r, int c) { const int st = (r >> 4) * 2 + (c >> 5), rr = r & 15, cc = c & 31, ob = rr * 64 + cc * 2; return st * 1024 + (ob ^ (((ob >> 9) & 1) << 5)); }
__host__ __device__ __forceinline__ void stage_rc(int b, int& R, int& C) { const int st = b / 1024, sb = b % 1024, swz = sb ^ (((sb >> 9) & 1) << 5); R = (st >> 1) * 16 + swz / 64; C = (st & 1) * 32 + (swz % 64) / 2; }
__host__ __device__ __forceinline__ int perm32(int rho) { const int n = rho >> 4, i = rho & 15; return 8 * (i >> 2) + 4 * n + (i & 3); }

struct Unit { int pm, pn; };
struct Gemm { const bf16_t* A; const bf16_t* Bt; int M, N, K; };

struct StaticOrder {
    int nM, nN, nwg, G, c;
    __host__ __device__ void init(int M, int N, int G_, int c_) { nM = M / BM; nN = N / BM; nwg = nM * nN; G = G_; c = c_; }
    __host__ __device__ bool next(int i, Unit& u) const {
        const long L = (long)i * G + c; if (L >= nwg) return false;
        int wgid = (int)L; { const int q = nwg / NXCD, r = nwg % NXCD, xcd = wgid % NXCD, off = wgid / NXCD; wgid = (xcd < r ? xcd * (q + 1) : r * (q + 1) + (xcd - r) * q) + off; }
        const int nig = WGM * nN, gid = wgid / nig, fm = gid * WGM, gsz = (nM - fm) < WGM ? (nM - fm) : WGM;
        u.pm = fm + ((wgid % nig) % gsz); u.pn = (wgid % nig) / gsz; return true;
    }
    __device__ __forceinline__ void a_ready(const Unit&) const {}
    __device__ __forceinline__ void done(const Unit&) const {}
};

__device__ __forceinline__ unsigned cvt_pk_bf16(float lo, float hi) { unsigned r; asm volatile("v_cvt_pk_bf16_f32 %0, %1, %2" : "=v"(r) : "v"(lo), "v"(hi)); return r; }
typedef float f32x2 __attribute__((ext_vector_type(2)));
__device__ __forceinline__ f32x2 gelu_pk(f32x2 v) {
    const f32x2 av = __builtin_elementwise_abs(v), d = av * 0.2316418882f + 1.0f;
    f32x2 t; t.x = __builtin_amdgcn_rcpf(d.x); t.y = __builtin_amdgcn_rcpf(d.y);
    f32x2 q = t * 0.5307027145f + (-0.7265760135f); q = q * t + 0.7107068705f; q = q * t + (-0.142248368f); q = q * t + 0.127414796f; q = q * t;
    const f32x2 s = (v * v) * (-0.72134752044f);
    f32x2 e; e.x = __builtin_amdgcn_exp2f(s.x); e.y = __builtin_amdgcn_exp2f(s.y);
    const f32x2 m = v * (q * e), r = v - m;
    f32x2 o; o.x = v.x < 0.f ? m.x : r.x; o.y = v.y < 0.f ? m.y : r.y; return o;
}
typedef unsigned u32x2 __attribute__((ext_vector_type(2)));
__device__ __forceinline__ float silu1(float v) { return v * __builtin_amdgcn_rcpf(1.0f + __builtin_amdgcn_exp2f(v * -1.4426950408889634f)); }
struct EpiProj {
    static constexpr bool PERM = true, AFTER_DRAIN = false;
    bf16_t* O; const float* cs;
    __device__ __forceinline__ void operator()(const f32x4 (&acc)[2][2][4][2], const Unit& u, int wr, int wc, int fr, int fq) const {
        const int t = u.pn >> 1, colt = (u.pn & 1) * BM;
        bf16_t* base = O + (size_t)t * BUF_STRIDE;
        const int row0 = u.pm * BM + wr * 64 + fr;
        if (t == 3 || t == 4) {
            const float sc = (t == 3) ? QSCALE : 1.0f;
            const int g = 4 * (wc & 1) + fq;
#pragma unroll
            for (int ai = 0; ai < 2; ++ai)
#pragma unroll
                for (int m = 0; m < 4; ++m) {
                    const int row = row0 + ai * HALF + m * 16;
                    const f32x4 cv = *(const f32x4*)(cs + (size_t)row * 64 + g * 8), sv = *(const f32x4*)(cs + (size_t)row * 64 + g * 8 + 4);
#pragma unroll
                    for (int bj = 0; bj < 2; ++bj) {
                        const f32x4 x1 = acc[ai][bj][m][0], x2 = acc[ai][bj][m][1];
                        const f32x4 o1 = (x1 * cv - x2 * sv) * sc, o2 = (x2 * cv + x1 * sv) * sc;
                        bf16_t* p = base + (size_t)row * 512 + colt + bj * HALF + (wc >> 1) * 64 + 4 * g;
                        u32x2 w1, w2; w1.x = cvt_pk_bf16(o1[0], o1[1]); w1.y = cvt_pk_bf16(o1[2], o1[3]); w2.x = cvt_pk_bf16(o2[0], o2[1]); w2.y = cvt_pk_bf16(o2[2], o2[3]);
                        *(u32x2*)p = w1; *(u32x2*)(p + 32) = w2;
                    }
                }
        } else {
            const int col0 = colt + wc * 32 + 8 * fq;
#pragma unroll
            for (int ai = 0; ai < 2; ++ai)
#pragma unroll
                for (int m = 0; m < 4; ++m) {
                    bf16_t* rowp = base + (size_t)(row0 + ai * HALF + m * 16) * 512 + col0;
#pragma unroll
                    for (int bj = 0; bj < 2; ++bj) {
                        f32x4 v0 = acc[ai][bj][m][0], v1 = acc[ai][bj][m][1];
                        if (t <= 1) { const f32x2 a = gelu_pk((f32x2){v0[0], v0[1]}), b = gelu_pk((f32x2){v0[2], v0[3]}), c = gelu_pk((f32x2){v1[0], v1[1]}), d = gelu_pk((f32x2){v1[2], v1[3]});
                            v0 = (f32x4){a.x, a.y, b.x, b.y}; v1 = (f32x4){c.x, c.y, d.x, d.y}; }
                        else if (t != 5) {
#pragma unroll
                            for (int e = 0; e < 4; ++e) { v0[e] = silu1(v0[e]); v1[e] = silu1(v1[e]); } }
                        u32x4 w; w.x = cvt_pk_bf16(v0[0], v0[1]); w.y = cvt_pk_bf16(v0[2], v0[3]); w.z = cvt_pk_bf16(v1[0], v1[1]); w.w = cvt_pk_bf16(v1[2], v1[3]);
                        *(u32x4*)(rowp + bj * HALF) = w;
                    }
                }
        }
    }
};
struct EpiOut {
    static constexpr bool PERM = false, AFTER_DRAIN = false;
    const float* x; float* out; const float* gate;
    __device__ __forceinline__ void operator()(const f32x4 (&acc)[2][2][4][2], const Unit& u, int wr, int wc, int fr, int fq) const {
        const int b = (u.pm * BM) / 8192, col0 = u.pn * BM + wc * 32 + 4 * fq;
        f32x4 gv[2][2];
#pragma unroll
        for (int bj = 0; bj < 2; ++bj)
#pragma unroll
            for (int n = 0; n < 2; ++n) gv[bj][n] = *(const f32x4*)(gate + b * 3072 + col0 + bj * HALF + n * 16);
#pragma unroll
        for (int ai = 0; ai < 2; ++ai)
#pragma unroll
            for (int m = 0; m < 4; ++m) {
                const size_t off = (size_t)(u.pm * BM + ai * HALF + wr * 64 + m * 16 + fr) * 1024 + col0;
#pragma unroll
                for (int bj = 0; bj < 2; ++bj)
#pragma unroll
                    for (int n = 0; n < 2; ++n) { const f32x4 xv = *(const f32x4*)(x + off + bj * HALF + n * 16); *(f32x4*)(out + off + bj * HALF + n * 16) = xv + gv[bj][n] * acc[ai][bj][m][n]; }
            }
    }
};

template <class Epi, class Sched, bool ALIGN_EPI = false, bool SP2 = false>
__device__ __forceinline__ void gemm_phase(PG8_LAS unsigned char* lds, const Gemm g, const Sched& S, const Epi& E) {
    const int tid = threadIdx.x, wid = __builtin_amdgcn_readfirstlane(tid >> 6), lane = tid & 63, wr = wid >> 2, wc = wid & 3, fr = lane & 15, fq = lane >> 4;
    const int K = g.K, nt = K / BK;
    unsigned voffA[2], voffB[2];
#pragma unroll
    for (int i = 0; i < 2; ++i) { int R, C; stage_rc(tid * 16 + i * 8192, R, C); const int Rb = Epi::PERM ? ((R & ~31) + perm32(R & 31)) : R;
        voffA[i] = (unsigned)(R * K + C) * 2u; voffB[i] = (unsigned)(Rb * K + C) * 2u; }
    const size_t kstep = (size_t)(BK * 2);
    const size_t hstep = (size_t)HALF * K * 2;
    const size_t tstep = 2 * hstep;
    const unsigned ldsw = (unsigned)wid * 1024u;
    const int aoff = lds_byte(wr * 64 + fr, fq * 8), boff = lds_byte(wc * 32 + fr, fq * 8);
#define PG8_SA(b, h) (((b) * 2 + (h)) * HTB)
#define PG8_SB(b, h) ((4 + (b) * 2 + (h)) * HTB)
#define PG8_STAGE(bufoff, gbase, voff) do { _Pragma("unroll") for (int _i = 0; _i < 2; ++_i) \
        __builtin_amdgcn_global_load_lds((const unsigned*)((const char*)(gbase) + (voff)[_i]), (PG8_LAS unsigned*)(lds + (bufoff) + ldsw + _i * 8192), 16, 0, 0); } while (0)
#define PG8_LDA(dst, b, h) do { _Pragma("unroll") for (int m = 0; m < 4; ++m) _Pragma("unroll") for (int k = 0; k < 2; ++k) dst[m][k] = *(const PG8_LAS bf16x8*)(lds + PG8_SA(b, h) + aoff + m * 2048 + k * 1024); } while (0)
#define PG8_LDB(dst, b, h) do { _Pragma("unroll") for (int n = 0; n < 2; ++n) _Pragma("unroll") for (int k = 0; k < 2; ++k) dst[n][k] = *(const PG8_LAS bf16x8*)(lds + PG8_SB(b, h) + boff + n * 2048 + k * 1024); } while (0)
#define PG8_MMA(ai, bj, At, Bt) do { __builtin_amdgcn_s_setprio(1); _Pragma("unroll") for (int m = 0; m < 4; ++m) _Pragma("unroll") for (int n = 0; n < 2; ++n) _Pragma("unroll") for (int k = 0; k < 2; ++k) \
        acc[ai][bj][m][n] = __builtin_amdgcn_mfma_f32_16x16x32_bf16(Bt[n][k], At[m][k], acc[ai][bj][m][n], 0, 0, 0); __builtin_amdgcn_s_setprio(0); } while (0)
#define PG8_WAIT_V(n) asm volatile("s_waitcnt vmcnt(" #n ")" ::: "memory")
#define PG8_WAIT_L(n) asm volatile("s_waitcnt lgkmcnt(" #n ")" ::: "memory")
#define PG8_BAR __builtin_amdgcn_s_barrier()
#define PG8_SCHED __builtin_amdgcn_sched_barrier(0)
    Unit cur, nxt; int ui = 0;
    if (!S.next(0, cur)) return;
    f32x4 acc[2][2][4][2];
#pragma unroll
    for (int a = 0; a < 2; ++a)
#pragma unroll
        for (int b = 0; b < 2; ++b)
#pragma unroll
            for (int m = 0; m < 4; ++m)
#pragma unroll
                for (int n = 0; n < 2; ++n) acc[a][b][m][n] = (f32x4){0.f, 0.f, 0.f, 0.f};
    bf16x8 At[4][2], B0[2][2], B1[2][2];
    const char* cA = (const char*)g.A + (size_t)cur.pm * tstep; const char* cB = (const char*)g.Bt + (size_t)cur.pn * tstep;
    S.a_ready(cur);
    if constexpr (SP2) {
        PG8_STAGE(PG8_SB(0, 0), cB, voffB); PG8_STAGE(PG8_SB(0, 1), cB + hstep, voffB); PG8_STAGE(PG8_SA(0, 0), cA, voffA); PG8_STAGE(PG8_SA(0, 1), cA + hstep, voffA);
        if (wr == 1) PG8_BAR;
        PG8_WAIT_V(2); PG8_BAR;
        PG8_STAGE(PG8_SB(1, 0), cB + kstep, voffB); PG8_STAGE(PG8_SA(1, 0), cA + kstep, voffA); PG8_STAGE(PG8_SB(1, 1), cB + hstep + kstep, voffB);
        PG8_WAIT_V(6); PG8_BAR;
    } else {
        PG8_STAGE(PG8_SB(0, 0), cB, voffB); PG8_STAGE(PG8_SA(0, 0), cA, voffA); PG8_STAGE(PG8_SB(0, 1), cB + hstep, voffB); PG8_STAGE(PG8_SA(0, 1), cA + hstep, voffA);
        if (wr == 1) PG8_BAR;
        PG8_WAIT_V(4); PG8_BAR;
        PG8_STAGE(PG8_SB(1, 0), cB + kstep, voffB); PG8_STAGE(PG8_SA(1, 0), cA + kstep, voffA); PG8_STAGE(PG8_SB(1, 1), cB + hstep + kstep, voffB);
        PG8_WAIT_V(6); PG8_BAR;
    }
    for (;;) {
        const bool has_next = S.next(ui + 1, nxt);
        const char* nA = has_next ? (const char*)g.A + (size_t)nxt.pm * tstep : cA; const char* nB = has_next ? (const char*)g.Bt + (size_t)nxt.pn * tstep : cB;
        for (int t = 0; t < nt; t += 2) {
            const bool last = (t == nt - 2);
            const char* a1 = cA + (size_t)(t + 1) * kstep;
            const char* a2 = last ? nA : cA + (size_t)(t + 2) * kstep; const char* b2 = last ? nB : cB + (size_t)(t + 2) * kstep;
            const char* a3 = a2 + kstep; const char* b3 = b2 + kstep;
            if (last && has_next) S.a_ready(nxt);
            if constexpr (SP2) {
            PG8_LDB(B0, 0, 0); PG8_LDB(B1, 0, 1); PG8_SCHED; PG8_LDA(At, 0, 0); PG8_STAGE(PG8_SA(1, 1), a1 + hstep, voffA);
            PG8_WAIT_V(8); PG8_WAIT_L(0); PG8_BAR; PG8_MMA(0, 0, At, B0); PG8_MMA(0, 1, At, B1); PG8_BAR; PG8_SCHED;
            PG8_LDA(At, 0, 1); PG8_STAGE(PG8_SB(0, 0), b2, voffB); PG8_STAGE(PG8_SB(0, 1), b2 + hstep, voffB); PG8_STAGE(PG8_SA(0, 0), a2, voffA);
            PG8_WAIT_V(8); PG8_WAIT_L(0); PG8_BAR; PG8_MMA(1, 0, At, B0); PG8_MMA(1, 1, At, B1); PG8_BAR; PG8_SCHED;
            PG8_LDB(B0, 1, 0); PG8_LDB(B1, 1, 1); PG8_SCHED; PG8_LDA(At, 1, 0); PG8_STAGE(PG8_SA(0, 1), a2 + hstep, voffA);
            PG8_WAIT_V(8); PG8_WAIT_L(0); PG8_BAR; PG8_MMA(0, 0, At, B0); PG8_MMA(0, 1, At, B1); PG8_BAR; PG8_SCHED;
            PG8_LDA(At, 1, 1); PG8_STAGE(PG8_SB(1, 0), b3, voffB); PG8_STAGE(PG8_SB(1, 1), b3 + hstep, voffB); PG8_STAGE(PG8_SA(1, 0), a3, voffA);
            PG8_WAIT_V(8); PG8_WAIT_L(0); PG8_BAR; PG8_MMA(1, 0, At, B0); PG8_MMA(1, 1, At, B1); PG8_BAR; PG8_SCHED;
            } else {
            PG8_LDB(B0, 0, 0); PG8_SCHED; PG8_LDA(At, 0, 0); PG8_STAGE(PG8_SA(1, 1), a1 + hstep, voffA);
            PG8_WAIT_L(8); PG8_BAR; PG8_WAIT_L(0); PG8_MMA(0, 0, At, B0); PG8_BAR; PG8_SCHED;
            PG8_LDB(B1, 0, 1); PG8_STAGE(PG8_SB(0, 0), b2, voffB);
            PG8_BAR; PG8_WAIT_L(0); PG8_MMA(0, 1, At, B1); PG8_BAR;
            PG8_LDA(At, 0, 1); PG8_STAGE(PG8_SA(0, 0), a2, voffA);
            PG8_BAR; PG8_WAIT_L(0); PG8_MMA(1, 0, At, B0); PG8_BAR; PG8_SCHED;
            PG8_STAGE(PG8_SB(0, 1), b2 + hstep, voffB);
            PG8_WAIT_V(6); PG8_BAR; PG8_MMA(1, 1, At, B1); PG8_BAR;
            PG8_LDB(B0, 1, 0); PG8_SCHED; PG8_LDA(At, 1, 0); PG8_STAGE(PG8_SA(0, 1), a2 + hstep, voffA);
            PG8_WAIT_L(8); PG8_BAR; PG8_WAIT_L(0); PG8_MMA(0, 0, At, B0); PG8_BAR; PG8_SCHED;
            PG8_LDB(B1, 1, 1); PG8_STAGE(PG8_SB(1, 0), b3, voffB);
            PG8_BAR; PG8_WAIT_L(0); PG8_MMA(0, 1, At, B1); PG8_BAR;
            PG8_LDA(At, 1, 1); PG8_STAGE(PG8_SA(1, 0), a3, voffA);
            PG8_BAR; PG8_WAIT_L(0); PG8_MMA(1, 0, At, B0); PG8_BAR; PG8_SCHED;
            PG8_STAGE(PG8_SB(1, 1), b3 + hstep, voffB);
            PG8_WAIT_V(6); PG8_BAR; PG8_MMA(1, 1, At, B1); PG8_BAR;
            }
        }
        if constexpr (ALIGN_EPI) { if (wr == 0) PG8_BAR; }
        if constexpr (!Epi::AFTER_DRAIN) { E(acc, cur, wr, wc, fr, fq); S.done(cur); }
        if (!has_next) break;
#pragma unroll
        for (int a = 0; a < 2; ++a)
#pragma unroll
            for (int b = 0; b < 2; ++b)
#pragma unroll
                for (int m = 0; m < 4; ++m)
#pragma unroll
                    for (int n = 0; n < 2; ++n) acc[a][b][m][n] = (f32x4){0.f, 0.f, 0.f, 0.f};
        cur = nxt; cA = nA; cB = nB; ++ui;
        if constexpr (ALIGN_EPI) { if (wr == 1) PG8_BAR; }
    }
    PG8_WAIT_V(0);
    if constexpr (!ALIGN_EPI) { if (wr == 0) PG8_BAR; }
    PG8_BAR;
    if constexpr (Epi::AFTER_DRAIN) { E.fused(acc, cur, wr, wc, fr, fq, lds, wid, lane); S.done(cur); }
#undef PG8_SA
#undef PG8_SB
#undef PG8_STAGE
#undef PG8_LDA
#undef PG8_LDB
#undef PG8_MMA
#undef PG8_WAIT_V
#undef PG8_WAIT_L
#undef PG8_BAR
#undef PG8_SCHED
}
}
namespace att {
typedef unsigned short bf16_t;
typedef short bf16x8 __attribute__((ext_vector_type(8)));
typedef short s16x4 __attribute__((ext_vector_type(4)));
typedef short v4i16_t __attribute__((ext_vector_type(4)));
typedef float f32x16 __attribute__((ext_vector_type(16)));
typedef unsigned u32x4 __attribute__((ext_vector_type(4)));
typedef float f32x2_t __attribute__((ext_vector_type(2))); typedef __bf16 bf16x2_t __attribute__((ext_vector_type(2)));
typedef __attribute__((address_space(3))) const char* lds_cptr;
#define MFMA32(a, b, c) __builtin_amdgcn_mfma_f32_32x32x16_bf16(a, b, c, 0, 0, 0)
__device__ __forceinline__ int crow(int r, int hi) { return (r & 3) + 8 * (r >> 2) + 4 * hi; }
__device__ __forceinline__ unsigned cvtpk(float lo, float hi) { f32x2_t v = {lo, hi}; bf16x2_t b = __builtin_convertvector(v, bf16x2_t); return __builtin_bit_cast(unsigned, b); }
__device__ __forceinline__ s16x4 vtr(lds_cptr p) { return __builtin_bit_cast(s16x4, __builtin_amdgcn_ds_read_tr16_b64_v4i16((__attribute__((address_space(3))) v4i16_t*)p)); }
__device__ __forceinline__ float bf2f(unsigned short b) { return __builtin_bit_cast(float, (unsigned)b << 16); }
__device__ __forceinline__ float lo2f(unsigned w) { return __builtin_bit_cast(float, w << 16); }
__device__ __forceinline__ float hi2f(unsigned w) { return __builtin_bit_cast(float, w & 0xffff0000u); }
#define MX3(a, b, c) __builtin_fmaxf(__builtin_fmaxf((a), (b)), (c))
__device__ __forceinline__ float rowmax(const f32x16& p0, const f32x16& p1) {
    float a = MX3(p0[0], p0[1], p1[0]), b = MX3(p0[2], p0[3], p1[1]); a = MX3(a, p1[2], p1[3]);
#pragma unroll
    for (int r = 4; r < 16; r += 4) { a = MX3(a, p0[r], p0[r + 1]); b = MX3(b, p0[r + 2], p0[r + 3]); a = MX3(a, p1[r], p1[r + 1]); b = MX3(b, p1[r + 2], p1[r + 3]); }
    float m = __builtin_fmaxf(a, b); auto rr = __builtin_amdgcn_permlane32_swap(__float_as_uint(m), __float_as_uint(m), false, false);
    return __builtin_fmaxf(__uint_as_float(rr[0]), __uint_as_float(rr[1])); }
constexpr int LDS_K = 0, LDS_V = 16384, LDS_S1 = 0, LDS_STG = 65536, LDS_WS = 98304, LDS_BYTES = 98304 + 2048;

__device__ __forceinline__ void attn_unit(int b, int h, int qb, const bf16_t* Q, const bf16_t* K, const bf16_t* V, const bf16_t* SZB, bf16_t* Y, const float* subg, float lam, char* shm) {
    const int tid = threadIdx.x, lane = tid & 63, r32 = lane & 31, hi = lane >> 5; const int wid = __builtin_amdgcn_readfirstlane(tid >> 6);
    const int t = wid >> 2, wq = wid & 3, hh = 2 * h + t;
    const long rowbase = (long)b * SEQ; const int q0 = qb * 128;
    const bf16_t* Qw = Q + (rowbase + q0 + wq * 32 + r32) * 512 + hh * 64 + hi * 8;
    bf16x8 qr[4];
#pragma unroll
    for (int d0 = 0; d0 < 4; ++d0) qr[d0] = *reinterpret_cast<const bf16x8*>(Qw + d0 * 16);
    f32x16 o[4];
#pragma unroll
    for (int d0 = 0; d0 < 4; ++d0) o[d0] = f32x16{};
    float mrun = -1e30f, l = 0.f;
    float* wsf = (float*)(shm + LDS_WS) + wid * 64;
    const int NT = 2 * qb + 2, myNT = 2 * qb + 1 + (wq >> 1);
    const lds_cptr shm3 = (lds_cptr)shm;
    const lds_cptr kp0 = shm3 + LDS_K + t * 8192 + hi * 1024 + r32 * 16;
    const lds_cptr vp0 = shm3 + LDS_V + ((lane >> 4) & 1) * 32 + (lane & 3) * 8 + (4 * hi + ((lane & 15) >> 2)) * 64;
    for (int tile = 0; tile < NT; ++tile) {
        __syncthreads();
        { const long key0 = rowbase + (long)tile * 64;
          const bf16_t* ks = K + (key0 + lane) * 512 + (2 * h) * 64 + wid * 8;
          const u32x4 k0v = *(const u32x4*)ks, k1v = *(const u32x4*)(ks + 64);
          *(u32x4*)(shm + LDS_K + wid * 1024 + lane * 16) = k0v; *(u32x4*)(shm + LDS_K + 8192 + wid * 1024 + lane * 16) = k1v;
#pragma unroll
          for (int i = 0; i < 2; ++i) { const int wp = wid + 8 * i;
              const bf16_t* vs = V + (key0 + 16 * (wp & 3) + (lane >> 2)) * 512 + h * 128 + (wp >> 2) * 32 + (lane & 3) * 8;
              *(u32x4*)(shm + LDS_V + wp * 1024 + lane * 16) = *(const u32x4*)vs; } }
        __syncthreads();
        if (tile < myNT) {
            f32x16 p0 = f32x16{}, p1 = f32x16{};
#pragma unroll
            for (int d0 = 0; d0 < 4; ++d0) {
                const bf16x8 b0 = *(const __attribute__((address_space(3))) bf16x8*)(kp0 + d0 * 2048);
                const bf16x8 b1 = *(const __attribute__((address_space(3))) bf16x8*)(kp0 + d0 * 2048 + 512);
                p0 = MFMA32(b0, qr[d0], p0); p1 = MFMA32(b1, qr[d0], p1); }
            const float rm = rowmax(p0, p1);
            const float mn = __builtin_fmaxf(mrun, rm);
            const float alpha = __builtin_amdgcn_exp2f(mrun - mn); mrun = mn;
            float sum = 0.f;
#pragma unroll
            for (int r = 0; r < 16; ++r) { p0[r] = __builtin_amdgcn_exp2f(p0[r] - mn); p1[r] = __builtin_amdgcn_exp2f(p1[r] - mn); sum += p0[r] + p1[r]; }
            l = l * alpha + sum;
            if (__any(alpha != 1.0f)) {
                if (hi == 0) wsf[r32] = alpha;
                asm volatile("s_waitcnt lgkmcnt(0)" ::: "memory");
#pragma unroll
                for (int r = 0; r < 16; ++r) { const float a = wsf[crow(r, hi)];
#pragma unroll
                    for (int d0 = 0; d0 < 4; ++d0) o[d0][r] *= a; }
            }
            u32x4 pw[4];
#pragma unroll
            for (int i = 0; i < 4; ++i) { pw[0][i] = cvtpk(p0[2 * i], p0[2 * i + 1]); pw[1][i] = cvtpk(p0[8 + 2 * i], p0[9 + 2 * i]); pw[2][i] = cvtpk(p1[2 * i], p1[2 * i + 1]); pw[3][i] = cvtpk(p1[8 + 2 * i], p1[9 + 2 * i]); }
#pragma unroll
            for (int d0 = 0; d0 < 4; ++d0)
#pragma unroll
                for (int ks = 0; ks < 4; ++ks) {
                    const s16x4 vl = vtr(vp0 + d0 * 4096 + ks * 1024), vh = vtr(vp0 + d0 * 4096 + ks * 1024 + 512);
                    const bf16x8 vf = (bf16x8){vl[0], vl[1], vl[2], vl[3], vh[0], vh[1], vh[2], vh[3]};
                    o[d0] = MFMA32(__builtin_bit_cast(bf16x8, pw[ks]), vf, o[d0]); }
        }
    }
    { auto rr = __builtin_amdgcn_permlane32_swap(__float_as_uint(l), __float_as_uint(l), false, false); l = __uint_as_float(rr[0]) + __uint_as_float(rr[1]); }
    if (hi == 0) wsf[32 + r32] = l;
    asm volatile("s_waitcnt lgkmcnt(0)" ::: "memory");
    float rli[16];
#pragma unroll
    for (int r = 0; r < 16; ++r) rli[r] = 1.0f / wsf[32 + crow(r, hi)];
    __syncthreads();
    float* S1 = (float*)(shm + LDS_S1);
    if (t == 1) {
#pragma unroll
        for (int d0 = 0; d0 < 4; ++d0)
#pragma unroll
            for (int r = 0; r < 16; ++r) S1[(wq * 32 + crow(r, hi)) * 128 + d0 * 32 + r32] = lam * o[d0][r] * rli[r];
    }
    __syncthreads();
    if (t == 0) {
        float rinv[16];
#pragma unroll
        for (int r = 0; r < 16; ++r) { float ss = 0.f;
#pragma unroll
            for (int d0 = 0; d0 < 4; ++d0) { const float d = o[d0][r] * rli[r] - S1[(wq * 32 + crow(r, hi)) * 128 + d0 * 32 + r32]; o[d0][r] = d; ss += d * d; }
            ss += __shfl_xor(ss, 1); ss += __shfl_xor(ss, 2); ss += __shfl_xor(ss, 4); ss += __shfl_xor(ss, 8); ss += __shfl_xor(ss, 16);
            rinv[r] = 1.0f / sqrtf(ss * (1.0f / 128.0f) + EPS); }
        bf16_t* stg = (bf16_t*)(shm + LDS_STG) + wq * 4096;
#pragma unroll
        for (int d0 = 0; d0 < 4; ++d0) { const float gsc = subg[d0 * 32 + r32] * (1.0f - LAM_INIT);
#pragma unroll
            for (int r = 0; r < 16; ++r) { const unsigned w = cvtpk(o[d0][r] * rinv[r] * gsc, 0.f); stg[crow(r, hi) * 128 + d0 * 32 + r32] = (bf16_t)(w & 0xffffu); } }
        asm volatile("s_waitcnt lgkmcnt(0)" ::: "memory");
#pragma unroll
        for (int i = 0; i < 8; ++i) { const int row = i * 4 + (lane >> 4), ch = lane & 15;
            const u32x4 sv = *(const u32x4*)(stg + row * 128 + ch * 8);
            const long grow = rowbase + q0 + wq * 32 + row;
            const u32x4 zv = *(const u32x4*)(SZB + grow * 512 + h * 128 + ch * 8);
            u32x4 ov;
#pragma unroll
            for (int e = 0; e < 4; ++e) ov[e] = cvtpk(lo2f(sv[e]) * lo2f(zv[e]), hi2f(sv[e]) * hi2f(zv[e]));
            *(u32x4*)(Y + grow * 1024 + 512 + h * 128 + ch * 8) = ov; }
    }
    __syncthreads();
}


constexpr int PSLOT = 16384;
constexpr int PLDS_K = 0, PLDS_V = 3 * PSLOT;
#define SBAR() __builtin_amdgcn_sched_barrier(0)
#define PIN(x) asm volatile("" : "+v"(x))
#define WAIT_BAR(N) asm volatile("s_waitcnt vmcnt(" #N ") lgkmcnt(0)\n\ts_barrier" ::: "memory")
__device__ __forceinline__ void glds16(const void* gsrc, unsigned lds_dst) { unsigned keep;
    asm volatile("s_mov_b32 %0, m0\n\ts_mov_b32 m0, %2\n\ts_nop 0\n\tglobal_load_lds_dwordx4 %1, off\n\ts_mov_b32 m0, %0" : "=&s"(keep) : "v"(gsrc), "s"(lds_dst) : "memory"); }
__device__ __forceinline__ void kload2(bf16x8* kf, lds_cptr kp, int j) { kf[2 * j] = *(const __attribute__((address_space(3))) bf16x8*)(kp + j * 2048); kf[2 * j + 1] = *(const __attribute__((address_space(3))) bf16x8*)(kp + j * 2048 + 512); }

template <int THRL>
__device__ __forceinline__ void attn_unit_p(int b, int h, int qb, const bf16_t* Q, const bf16_t* __restrict__ K, const bf16_t* __restrict__ V, const bf16_t* SZB, bf16_t* Y, const float* subg, float lam, char* shm) {
    const int tid = threadIdx.x, lane = tid & 63, r32 = lane & 31, hi = lane >> 5; const int wid = __builtin_amdgcn_readfirstlane(tid >> 6);
    const int t_c = wid >> 2, wq = wid & 3, hh = 2 * h + t_c;
    const long rowbase = (long)b * SEQ; const int q0 = qb * 128;
    const bf16_t* Qw = Q + (rowbase + q0 + wq * 32 + r32) * 512 + hh * 64 + hi * 8;
    const unsigned lds0 = (unsigned)(uintptr_t)shm;
    float* wsf = (float*)(shm + LDS_WS) + wid * 64;
    const bf16_t* ksrc = K + (rowbase + lane) * 512 + (2 * h) * 64 + wid * 8;
    const bf16_t* vsrc = V + (rowbase + 16 * (wid & 3) + (lane >> 2)) * 512 + h * 128 + (wid >> 2) * 32 + (lane & 3) * 8;
    const unsigned kdst = lds0 + PLDS_K + wid * 1024, vdst = lds0 + PLDS_V + wid * 1024;
#define DMA_K(t, slot) do { glds16(ksrc + (long)(t) * 64 * 512, (unsigned)__builtin_amdgcn_readfirstlane(kdst + (slot))); glds16(ksrc + 64 + (long)(t) * 64 * 512, (unsigned)__builtin_amdgcn_readfirstlane(kdst + (slot) + 8192)); } while (0)
#define DMA_V(t, slot) do { glds16(vsrc + (long)(t) * 64 * 512, (unsigned)__builtin_amdgcn_readfirstlane(vdst + (slot))); glds16(vsrc + 64 + (long)(t) * 64 * 512, (unsigned)__builtin_amdgcn_readfirstlane(vdst + (slot) + 8192)); } while (0)
    const lds_cptr shm3 = (lds_cptr)shm;
    const lds_cptr kp0 = shm3 + PLDS_K + t_c * 8192 + hi * 1024 + r32 * 16;
    const lds_cptr vp0 = shm3 + PLDS_V + ((lane >> 4) & 1) * 32 + (lane & 3) * 8 + (4 * hi + ((lane & 15) >> 2)) * 64;
    const int NT = 2 * qb + 2;
    DMA_K(0, 0); DMA_V(0, 0); DMA_K(1, PSLOT);
    bf16x8 qr[4];
#pragma unroll
    for (int d0 = 0; d0 < 4; ++d0) qr[d0] = *reinterpret_cast<const bf16x8*>(Qw + d0 * 16);
    float mhat = 0.f, l_reg = 0.f; f32x16 o[4];
#pragma unroll
    for (int d0 = 0; d0 < 4; ++d0) o[d0] = f32x16{};
    f32x16 negm;
    bool resc = false;
    f32x16 pA0, pA1, pB0, pB1; bf16x8 kf[8]; s16x4 vlo[4], vhi[4]; u32x4 pw0, pw1, pw2, pw3;
    int sl_prev = 0, sl_cur = 0, sl_next = PSLOT;
#define ROT() do { sl_prev = sl_cur; sl_cur = sl_next; sl_next = (sl_next == 2 * PSLOT) ? 0 : sl_next + PSLOT; } while (0)
#define RESC() do { if (resc) { asm volatile("s_waitcnt lgkmcnt(0)" ::: "memory"); \
      _Pragma("unroll") for (int d_ = 0; d_ < 4; ++d_) _Pragma("unroll") for (int r = 0; r < 16; ++r) o[d_][r] *= wsf[crow(r, hi)]; } } while (0)
    DMA_K(2, 2 * PSLOT);
    WAIT_BAR(6);
#pragma unroll
    for (int j = 0; j < 4; ++j) kload2(kf, kp0, j);
    pA0 = MFMA32(kf[0], qr[0], f32x16{}); pA1 = MFMA32(kf[1], qr[0], f32x16{}); pA0 = MFMA32(kf[2], qr[1], pA0); pA1 = MFMA32(kf[3], qr[1], pA1);
    pA0 = MFMA32(kf[4], qr[2], pA0); pA1 = MFMA32(kf[5], qr[2], pA1); pA0 = MFMA32(kf[6], qr[3], pA0); pA1 = MFMA32(kf[7], qr[3], pA1);
    { const float rm = rowmax(pA0, pA1); mhat = rm;
#pragma unroll
      for (int r = 0; r < 16; ++r) { pA0[r] = __builtin_amdgcn_exp2f(pA0[r] - rm); pA1[r] = __builtin_amdgcn_exp2f(pA1[r] - rm); }
#pragma unroll
      for (int r = 0; r < 16; ++r) negm[r] = -mhat;
      PIN(negm); }
    WAIT_BAR(0);
    DMA_K(3, 0); DMA_V(1, PSLOT); ROT();
#pragma unroll
    for (int j = 0; j < 4; ++j) kload2(kf, kp0 + sl_cur, j);
    if (NT == 2) { WAIT_BAR(0); } else { WAIT_BAR(4); }
#define PKW(P, i) cvtpk(P[i], P[(i) + 1])
#define PAF(k) __builtin_bit_cast(bf16x8, pw##k)
#define VFR(i) (bf16x8){vlo[i][0], vlo[i][1], vlo[i][2], vlo[i][3], vhi[i][0], vhi[i][1], vhi[i][2], vhi[i][3]}
#define VRDJ(s_, j_) do { vlo[s_] = vtr(vp_ + (((j_) >> 2) * 4096 + ((j_) & 3) * 1024)); vhi[s_] = vtr(vp_ + (((j_) >> 2) * 4096 + ((j_) & 3) * 1024 + 512)); } while (0)
#define KRD(G, j) do { if (G) { kload2(kf, kp0 + sl_next, j); SBAR(); } } while (0)
#define EX(v) __builtin_amdgcn_exp2f(v)
#define GAPA(MF, a0, a1, a2, a3, W0, W1, PW) do { MF; sacc += a0; sacc += a1; sacc += a2; sacc += a3; PIN(sacc); W0; W1; PIN(PW); SBAR(); } while (0)
#define GAPB(j_, X, B) do { o[(j_) >> 2] = MFMA32(PAF4((j_) & 3), VFR((j_) & 3), o[(j_) >> 2]); if ((j_) < 12) { VRDJ((j_) & 3, (j_) + 4); } X[B] = EX(X[B]); X[(B) + 1] = EX(X[(B) + 1]); PIN(X); SBAR(); } while (0)
#define PAF4(k) __builtin_bit_cast(bf16x8, (k) == 0 ? pw0 : (k) == 1 ? pw1 : (k) == 2 ? pw2 : pw3)
#define STEP(C0, C1, P0, P1, t, MASK, GK, GV, GL) do { SBAR(); \
    const lds_cptr vp_ = vp0 + sl_prev; \
    VRDJ(0, 0); SBAR(); float sacc = (P0[0] + P0[1]); \
                        GAPA(C0 = MFMA32(kf[0], qr[0], negm), P0[2], P0[3], P0[4], P0[5],     pw0[0] = PKW(P0, 0),  pw0[1] = PKW(P0, 2),  pw0); \
                        GAPA(C1 = MFMA32(kf[1], qr[0], negm), P0[6], P0[7], P0[8], P0[9],     pw0[2] = PKW(P0, 4),  pw0[3] = PKW(P0, 6),  pw0); \
    VRDJ(1, 1); SBAR(); GAPA(C0 = MFMA32(kf[2], qr[1], C0),   P0[10], P0[11], P0[12], P0[13], pw1[0] = PKW(P0, 8),  pw1[1] = PKW(P0, 10), pw1); \
                        GAPA(C1 = MFMA32(kf[3], qr[1], C1),   P0[14], P0[15], P1[0], P1[1],   pw1[2] = PKW(P0, 12), pw1[3] = PKW(P0, 14), pw1); \
    VRDJ(2, 2); SBAR(); GAPA(C0 = MFMA32(kf[4], qr[2], C0),   P1[2], P1[3], P1[4], P1[5],     pw2[0] = PKW(P1, 0),  pw2[1] = PKW(P1, 2),  pw2); \
                        GAPA(C1 = MFMA32(kf[5], qr[2], C1),   P1[6], P1[7], P1[8], P1[9],     pw2[2] = PKW(P1, 4),  pw2[3] = PKW(P1, 6),  pw2); \
    VRDJ(3, 3); SBAR(); GAPA(C0 = MFMA32(kf[6], qr[3], C0),   P1[10], P1[11], P1[12], P1[13], pw3[0] = PKW(P1, 8),  pw3[1] = PKW(P1, 10), pw3); \
                        GAPA(C1 = MFMA32(kf[7], qr[3], C1),   P1[14], P1[15], 0.f, 0.f,       pw3[2] = PKW(P1, 12), pw3[3] = PKW(P1, 14), pw3); \
    l_reg += sacc; \
    if (GK) { DMA_K((t) + 3, sl_cur); } if (GV) { DMA_V((t) + 1, sl_next); } \
    if (MASK) { if (wq < 2) { _Pragma("unroll") for (int r = 0; r < 16; ++r) { C0[r] = -INFINITY; C1[r] = -INFINITY; } } } \
    { float a_ = MX3(C0[0], C0[1], C1[0]), b_ = MX3(C0[2], C0[3], C1[1]); a_ = MX3(a_, C1[2], C1[3]); \
      _Pragma("unroll") for (int r = 4; r < 16; r += 4) { a_ = MX3(a_, C0[r], C0[r + 1]); b_ = MX3(b_, C0[r + 2], C0[r + 3]); a_ = MX3(a_, C1[r], C1[r + 1]); b_ = MX3(b_, C1[r + 2], C1[r + 3]); } \
      float rm = __builtin_fmaxf(a_, b_); { auto rr = __builtin_amdgcn_permlane32_swap(__float_as_uint(rm), __float_as_uint(rm), false, false); rm = __builtin_fmaxf(__uint_as_float(rr[0]), __uint_as_float(rr[1])); } \
      resc = false; \
      if (__builtin_expect(__any(rm > (float)THRL), 0)) { const float dl = __builtin_fmaxf(rm, 0.f); mhat += dl; \
        _Pragma("unroll") for (int r = 0; r < 16; ++r) { C0[r] -= dl; C1[r] -= dl; } \
        _Pragma("unroll") for (int r = 0; r < 16; ++r) negm[r] = -mhat; PIN(negm); \
        const float f = __builtin_amdgcn_exp2f(-dl); l_reg *= f; if (hi == 0) wsf[r32] = f; resc = true; } } \
    SBAR(); \
    GAPB(0, C0, 0); GAPB(1, C0, 2); GAPB(2, C0, 4); GAPB(3, C0, 6); GAPB(4, C0, 8); GAPB(5, C0, 10); GAPB(6, C0, 12); GAPB(7, C0, 14); \
    KRD(GL, 0); GAPB(8, C1, 0); KRD(GL, 1); GAPB(9, C1, 2); KRD(GL, 2); GAPB(10, C1, 4); KRD(GL, 3); GAPB(11, C1, 6); \
    GAPB(12, C1, 8); GAPB(13, C1, 10); GAPB(14, C1, 12); GAPB(15, C1, 14); \
    } while (0)
    int t = 1;
    for (; t + 5 < NT; t += 2) {
        STEP(pB0, pB1, pA0, pA1, t, false, true, true, true);     WAIT_BAR(4); RESC(); ROT();
        STEP(pA0, pA1, pB0, pB1, t + 1, false, true, true, true); WAIT_BAR(4); RESC(); ROT();
    }
#define ENDW(tt) do { if ((tt) + 3 < NT) { WAIT_BAR(4); } else if ((tt) + 2 < NT) { WAIT_BAR(2); } else { WAIT_BAR(0); } } while (0)
    for (; t + 1 < NT; t += 2) {
        STEP(pB0, pB1, pA0, pA1, t, false, (t + 3 < NT), (t + 1 < NT), (t + 1 < NT));       ENDW(t);     RESC(); ROT();
        STEP(pA0, pA1, pB0, pB1, t + 1, false, (t + 4 < NT), (t + 2 < NT), (t + 2 < NT));   ENDW(t + 1); RESC(); ROT();
    }
    STEP(pB0, pB1, pA0, pA1, NT - 1, true, false, false, false); RESC();
    { float sacc = pB0[0] + pB0[1];
#pragma unroll
      for (int r = 2; r < 16; ++r) sacc += pB0[r];
#pragma unroll
      for (int r = 0; r < 16; ++r) sacc += pB1[r];
      l_reg += sacc;
      pw0 = (u32x4){PKW(pB0, 0), PKW(pB0, 2), PKW(pB0, 4), PKW(pB0, 6)}; pw1 = (u32x4){PKW(pB0, 8), PKW(pB0, 10), PKW(pB0, 12), PKW(pB0, 14)};
      pw2 = (u32x4){PKW(pB1, 0), PKW(pB1, 2), PKW(pB1, 4), PKW(pB1, 6)}; pw3 = (u32x4){PKW(pB1, 8), PKW(pB1, 10), PKW(pB1, 12), PKW(pB1, 14)};
      const lds_cptr vp_ = vp0 + sl_cur;
#pragma unroll
      for (int d0 = 0; d0 < 4; ++d0) {
#pragma unroll
          for (int i = 0; i < 4; ++i) VRDJ(i, 4 * d0 + i);
          o[d0] = MFMA32(PAF(0), VFR(0), o[d0]); o[d0] = MFMA32(PAF(1), VFR(1), o[d0]); o[d0] = MFMA32(PAF(2), VFR(2), o[d0]); o[d0] = MFMA32(PAF(3), VFR(3), o[d0]); } }
#undef PKW
#undef PAF
#undef VFR
#undef VRDJ
#undef PAF4
#undef KRD
#undef EX
#undef GAPA
#undef GAPB
#undef STEP
#undef ENDW
#undef DMA_K
#undef DMA_V
#undef ROT
#undef RESC
    int lane_e = lane; asm volatile("" : "+v"(lane_e));
    const int r32e = lane_e & 31, hie = lane_e >> 5;
    { auto rr = __builtin_amdgcn_permlane32_swap(__float_as_uint(l_reg), __float_as_uint(l_reg), false, false); l_reg = __uint_as_float(rr[0]) + __uint_as_float(rr[1]); }
    if (hie == 0) wsf[32 + r32e] = l_reg;
    asm volatile("s_waitcnt lgkmcnt(0)" ::: "memory");
    float rli[16];
#pragma unroll
    for (int r = 0; r < 16; ++r) rli[r] = 1.0f / wsf[32 + crow(r, hie)];
    asm volatile("s_waitcnt vmcnt(0) lgkmcnt(0)\n\ts_barrier" ::: "memory");
    float* S1 = (float*)(shm + LDS_S1);
    if (t_c == 1) {
#pragma unroll
        for (int d0 = 0; d0 < 4; ++d0)
#pragma unroll
            for (int r = 0; r < 16; ++r) S1[(wq * 32 + crow(r, hie)) * 128 + d0 * 32 + r32e] = lam * o[d0][r] * rli[r];
    }
    asm volatile("s_waitcnt lgkmcnt(0)\n\ts_barrier" ::: "memory");
    if (t_c == 0) {
        float rinv[16];
#pragma unroll
        for (int r = 0; r < 16; ++r) { float ss = 0.f;
#pragma unroll
            for (int d0 = 0; d0 < 4; ++d0) { const float d = o[d0][r] * rli[r] - S1[(wq * 32 + crow(r, hie)) * 128 + d0 * 32 + r32e]; o[d0][r] = d; ss += d * d; }
            ss += __shfl_xor(ss, 1); ss += __shfl_xor(ss, 2); ss += __shfl_xor(ss, 4); ss += __shfl_xor(ss, 8); ss += __shfl_xor(ss, 16);
            rinv[r] = 1.0f / sqrtf(ss * (1.0f / 128.0f) + EPS); }
        bf16_t* stg = (bf16_t*)(shm + LDS_STG) + wq * 4096;
#pragma unroll
        for (int d0 = 0; d0 < 4; ++d0) { const float gsc = subg[d0 * 32 + r32e] * (1.0f - LAM_INIT);
#pragma unroll
            for (int r = 0; r < 16; ++r) { const unsigned w = cvtpk(o[d0][r] * rinv[r] * gsc, 0.f); stg[crow(r, hie) * 128 + d0 * 32 + r32e] = (bf16_t)(w & 0xffffu); } }
        asm volatile("s_waitcnt lgkmcnt(0)" ::: "memory");
#pragma unroll
        for (int i = 0; i < 8; ++i) { const int row = i * 4 + (lane_e >> 4), ch = lane_e & 15;
            const u32x4 sv = *(const u32x4*)(stg + row * 128 + ch * 8);
            const long grow = rowbase + q0 + wq * 32 + row;
            const u32x4 zv = *(const u32x4*)(SZB + grow * 512 + h * 128 + ch * 8);
            u32x4 ov;
#pragma unroll
            for (int e = 0; e < 4; ++e) ov[e] = cvtpk(lo2f(sv[e]) * lo2f(zv[e]), hi2f(sv[e]) * hi2f(zv[e]));
            *(u32x4*)(Y + grow * 1024 + 512 + h * 128 + ch * 8) = ov; }
    }
    asm volatile("s_waitcnt vmcnt(0) lgkmcnt(0)\n\ts_barrier" ::: "memory");
}
#undef SBAR
#undef PIN
#undef WAIT_BAR

__device__ __forceinline__ void gmlp_unit(int win, int g, const bf16_t* GU, const bf16_t* GV, const bf16_t* SZA, const bf16_t* WSM, const float* lng, const float* lnb, const float* bs, bf16_t* Y, char* shm) {
    const int tid = threadIdx.x, lane = tid & 63, r32 = lane & 31, hi = lane >> 5; const int wid = __builtin_amdgcn_readfirstlane(tid >> 6);
    const long row0 = (long)win * 128;
#pragma unroll
    for (int i = 0; i < 4; ++i) {
        const int piece = tid + 512 * i, j = piece >> 4, ch = piece & 15;
        const u32x4 raw = *(const u32x4*)(GV + (row0 + j) * 512 + g * 128 + ch * 8);
        float x[8];
#pragma unroll
        for (int e = 0; e < 4; ++e) { x[2 * e] = lo2f(raw[e]); x[2 * e + 1] = hi2f(raw[e]); }
        float s = 0.f;
#pragma unroll
        for (int e = 0; e < 8; ++e) s += x[e];
        s += __shfl_xor(s, 1); s += __shfl_xor(s, 2); s += __shfl_xor(s, 4); s += __shfl_xor(s, 8);
        const float mean = s * (1.0f / 128.0f); float q = 0.f;
#pragma unroll
        for (int e = 0; e < 8; ++e) { x[e] -= mean; q += x[e] * x[e]; }
        q += __shfl_xor(q, 1); q += __shfl_xor(q, 2); q += __shfl_xor(q, 4); q += __shfl_xor(q, 8);
        const float rstd = 1.0f / sqrtf(q * (1.0f / 128.0f) + EPS);
        const float4 g0 = *(const float4*)(lng + g * 128 + ch * 8), g1 = *(const float4*)(lng + g * 128 + ch * 8 + 4);
        const float4 b0 = *(const float4*)(lnb + g * 128 + ch * 8), b1 = *(const float4*)(lnb + g * 128 + ch * 8 + 4);
        u32x4 w;
        w[0] = cvtpk(x[0] * rstd * g0.x + b0.x, x[1] * rstd * g0.y + b0.y); w[1] = cvtpk(x[2] * rstd * g0.z + b0.z, x[3] * rstd * g0.w + b0.w);
        w[2] = cvtpk(x[4] * rstd * g1.x + b1.x, x[5] * rstd * g1.y + b1.y); w[3] = cvtpk(x[6] * rstd * g1.z + b1.z, x[7] * rstd * g1.w + b1.w);
        *(u32x4*)(shm + (ch >> 2) * 8192 + j * 64 + (ch & 3) * 16) = w;
    }
    __syncthreads();
    const int ib = wid >> 1, cbh = wid & 1, ksteps = (ib < 2) ? 4 : 8;
    f32x16 acc[2]; acc[0] = f32x16{}; acc[1] = f32x16{};
    const lds_cptr vb = (lds_cptr)shm + (8 * hi + ((lane & 15) >> 2)) * 64 + ((lane >> 4) & 1) * 32 + (lane & 3) * 8;
    const bf16_t* wrow = WSM + ((size_t)g * 128 + ib * 32 + r32) * 128 + hi * 8;
    for (int s = 0; s < ksteps; ++s) {
        const bf16x8 a = *(const bf16x8*)(wrow + s * 16);
#pragma unroll
        for (int cc = 0; cc < 2; ++cc) { const int cb = 2 * cbh + cc;
            const s16x4 vl = vtr(vb + cb * 8192 + s * 1024), vh = vtr(vb + cb * 8192 + s * 1024 + 256);
            const bf16x8 vf = (bf16x8){vl[0], vl[1], vl[2], vl[3], vh[0], vh[1], vh[2], vh[3]};
            acc[cc] = MFMA32(a, vf, acc[cc]); }
    }
#pragma unroll
    for (int cc = 0; cc < 2; ++cc) { const int c = (2 * cbh + cc) * 32 + r32;
#pragma unroll
        for (int r = 0; r < 16; ++r) { const int i = ib * 32 + crow(r, hi); const long row = row0 + i;
            const float sv = acc[cc][r] + bs[g * 128 + i];
            const float u = bf2f(GU[row * 512 + g * 128 + c]), z = bf2f(SZA[row * 512 + g * 128 + c]);
            const unsigned w = cvtpk(u * sv * z, 0.f); Y[row * 1024 + g * 128 + c] = (bf16_t)(w & 0xffffu); } }
    __syncthreads();
}
#undef MX3
}


constexpr int NWAVES = 8;
constexpr int N_LAUNCHES = MK_N_LAUNCHES;
constexpr int PER_PHASE = 6;
constexpr size_t MiB = 1u << 20;
constexpr size_t WS_CTL = 0, CTL_ZERO_BYTES = 1 * MiB;
constexpr size_t WS_MOD = 1 * MiB;
constexpr size_t WS_CS = 2 * MiB;
constexpr size_t WS_WIN = 6 * MiB;
constexpr size_t WS_WOUT = 13 * MiB;
constexpr size_t WS_WSM = 15 * MiB;
constexpr size_t WS_H = 16 * MiB;
constexpr size_t WS_PROJ = 48 * MiB;
constexpr size_t WS_Y = 160 * MiB;
constexpr size_t WS_END = 192 * MiB;
constexpr int CW_BAR = 4096;
constexpr int RING_OFF = 0, RING_BYTES = 131072;
constexpr int LDSCTL_OFF = RING_BYTES, MISC_OFF = LDSCTL_OFF + 320;
constexpr int LDS_BYTES = 147456;

#define GAS __attribute__((address_space(1)))
#define LAS __attribute__((address_space(3)))
typedef unsigned short bf16;
typedef unsigned v4u __attribute__((ext_vector_type(4)));
typedef float f32x4 __attribute__((ext_vector_type(4)));
typedef short bf16x8 __attribute__((ext_vector_type(8)));
typedef GAS unsigned gu32;
typedef GAS unsigned long long gu64;
#define RLX_AGENT __ATOMIC_RELAXED, __HIP_MEMORY_SCOPE_AGENT
#define LDS_WAIT() asm volatile("s_waitcnt lgkmcnt(0)" ::: "memory")
#define VM_WAIT() asm volatile("s_waitcnt vmcnt(0)" ::: "memory")
__device__ __forceinline__ unsigned long long rt() { return __builtin_amdgcn_s_memrealtime(); }
__device__ __forceinline__ unsigned f2bf(float f) { unsigned u = __builtin_bit_cast(unsigned, f); return (u + 0x7fffu + ((u >> 16) & 1u)) >> 16; }
__device__ __forceinline__ unsigned pk2(float lo, float hi) { return f2bf(lo) | (f2bf(hi) << 16); }

#define XB_TMO      128
#define XB_XCNT(j)  (256  + 64 * (j))
#define XB_XSUB(j)  (1280 + 64 * (j))
#define XB_XGEN(j)  (2304 + 64 * (j))
#define XB_TOP      3328
#define XB_TOPGEN   3392
#define XCD_BAR_WORDS 3456
#define XB_SPIN_CAP (1u << 18)

__device__ __forceinline__ unsigned xb_ld(unsigned* p)              { return __hip_atomic_load(p, __ATOMIC_RELAXED, __HIP_MEMORY_SCOPE_AGENT); }
__device__ __forceinline__ unsigned xb_add(unsigned* p, unsigned v) { return __hip_atomic_fetch_add(p, v, __ATOMIC_RELAXED, __HIP_MEMORY_SCOPE_AGENT); }
__device__ __forceinline__ unsigned xb_xcc_id() { return (unsigned)__builtin_amdgcn_s_getreg((3 << 11) | 20) & 0xFu; }
#define XB_SPIN(cond, bar) do { unsigned _sp = 0; while (cond) { __builtin_amdgcn_s_sleep(1); \
    if ((++_sp & 255u) == 0u) { if (xb_ld(&(bar)[XB_TMO])) break; if (_sp > XB_SPIN_CAP) { atomicAdd(&(bar)[XB_TMO], 1u); break; } } } } while (0)

struct XcdBarrier {
    unsigned* bar; unsigned x;
    volatile LAS unsigned* st;
};

__device__ __forceinline__ XcdBarrier xcd_barrier_post(unsigned* bar, volatile LAS unsigned* st) {
    XcdBarrier b; b.bar = bar; b.x = xb_xcc_id(); b.st = st;
    if (threadIdx.x == 0) (void)xb_add(&bar[XB_XCNT(b.x)], 1u);
    return b;
}
__device__ __forceinline__ void xcd_barrier_complete(unsigned* bar, unsigned x, unsigned& nloc, unsigned& nx) {
    const unsigned G = gridDim.x * gridDim.y * gridDim.z;
    unsigned sum, cnt, mine, sp = 0u;
    for (;;) {
        sum = 0u; cnt = 0u; mine = 0u;
#pragma unroll
        for (unsigned j = 0; j < 16; ++j) { const unsigned c = xb_ld(&bar[XB_XCNT(j)]); sum += c; cnt += (c > 0u) ? 1u : 0u; mine = (j == x) ? c : mine; }
        if (sum == G) break;
        __builtin_amdgcn_s_sleep(1);
        if ((++sp & 255u) == 0u) { if (xb_ld(&bar[XB_TMO])) break; if (sp > XB_SPIN_CAP) { atomicAdd(&bar[XB_TMO], 1u); break; } }
    }
    nloc = mine > 0u ? mine : 1u; nx = cnt > 0u ? cnt : 1u;
}

__device__ __forceinline__ void xcd_barrier(const XcdBarrier& b) {
    asm volatile("s_waitcnt vmcnt(0)" ::: "memory");
    __syncthreads();
    if (threadIdx.x == 0) {
        unsigned* bar = b.bar;
        __builtin_amdgcn_s_waitcnt(0);
        unsigned nloc = b.st[0], nx = b.st[1];
        if (nloc == 0u) { xcd_barrier_complete(bar, b.x, nloc, nx); b.st[0] = nloc; b.st[1] = nx; }
        const unsigned old = xb_add(&bar[XB_XSUB(b.x)], 1u);
        const unsigned gen = old / nloc;
        if (old + 1u == (gen + 1u) * nloc) {
            __builtin_amdgcn_fence(__ATOMIC_RELEASE, "agent");
            asm volatile("s_waitcnt vmcnt(0)" ::: "memory");
            const unsigned og = xb_add(&bar[XB_TOP], 1u);
            const unsigned tg = og / nx;
            if (og + 1u == (tg + 1u) * nx) xb_add(&bar[XB_TOPGEN], 1u);
            else XB_SPIN(xb_ld(&bar[XB_TOPGEN]) == tg, bar);
            __builtin_amdgcn_fence(__ATOMIC_ACQUIRE, "agent");
            xb_add(&bar[XB_XGEN(b.x)], 1u);
            asm volatile("s_waitcnt vmcnt(0)" ::: "memory");
        } else {
            XB_SPIN(xb_ld(&bar[XB_XGEN(b.x)]) == gen, bar);
            __builtin_amdgcn_fence(__ATOMIC_ACQUIRE, "agent");
            asm volatile("s_waitcnt vmcnt(0)" ::: "memory");
        }
    }
    __syncthreads();
}

__device__ const double INV_REV[32] = {0.15915494309189535, 0.11934937021124886, 0.08949940160889101, 0.06711508300522726, 0.050329212104487035, 0.03774158471741977, 0.0283021958306234, 0.02122365276477766, 0.015915494309189534, 0.011934937021124886, 0.008949940160889102, 0.006711508300522725, 0.005032921210448704, 0.003774158471741977, 0.00283021958306234, 0.0021223652764777662, 0.0015915494309189536, 0.0011934937021124885, 0.0008949940160889102, 0.0006711508300522726, 0.0005032921210448703, 0.00037741584717419774, 0.00028302195830623395, 0.0002122365276477766, 0.00015915494309189535, 0.00011934937021124886, 8.949940160889102e-05, 6.711508300522725e-05, 5.0329212104487035e-05, 3.774158471741978e-05, 2.8302195830623396e-05, 2.122365276477766e-05};

struct Frame {
    LAS unsigned char* lds;
    volatile LAS unsigned* MISC;
    gu32* ctl;
    int tid, lane, wave;
    int vcu, G;
};
__device__ __forceinline__ float wave_sum(float v) {
#pragma unroll
    for (int o = 1; o < 64; o <<= 1) v += __shfl_xor(v, o);
    return v;
}
__device__ __forceinline__ int sigma_col(int n) {
    if (n < 1536 || n >= 2560) return n;
    const int p = n & 63, g = p >> 3, i = p & 7; return (n & ~63) + 4 * g + (i & 3) + 32 * (i >> 2);
}
template <bool SIG>
__device__ __forceinline__ void p0_transpose_item(const float* W, int K, int N, bf16* WT, LAS float* scr, int item, int lane) {
    const int nblk = N / 32, kb = item / nblk, nb = item % nblk, k0 = 64 * kb, n0 = 32 * nb;
    const int scol = SIG ? sigma_col(n0 + (lane & 31)) : n0 + (lane & 31);
#pragma unroll 8
    for (int i = 0; i < 32; ++i) { const int kk = 2 * i + (lane >> 5); scr[kk * 33 + (lane & 31)] = W[(size_t)(k0 + kk) * N + scol]; }
    LDS_WAIT(); asm volatile("" ::: "memory");
    const int c = lane & 7;
#pragma unroll
    for (int j = 0; j < 4; ++j) { const int n = (lane >> 3) + 8 * j; const LAS float* s = scr + (8 * c) * 33 + n;
        v4u o; o.x = pk2(s[0 * 33], s[1 * 33]); o.y = pk2(s[2 * 33], s[3 * 33]); o.z = pk2(s[4 * 33], s[5 * 33]); o.w = pk2(s[6 * 33], s[7 * 33]);
        *(GAS v4u*)(WT + (size_t)(n0 + n) * K + k0 + 8 * c) = o; }
    LDS_WAIT(); asm volatile("" ::: "memory");
}
constexpr int NGEMV_WG = 48;
struct Ptrs {
    const float *x, *c, *w_ada, *b_ada, *norm_g, *w_in, *ln_g, *ln_b, *gws, *gbs, *lq1, *lk1, *lq2, *lk2, *subg, *w_out, *fin_g; const int* pos;
    float* out; float* mod; float* cs; bf16 *win_t, *wout_t, *wsm, *H, *proj, *Y;
};
__device__ __forceinline__ void p0_prologue(Frame& F, const Ptrs& P) {
    { const int gt = F.vcu * (NWAVES * 64) + F.tid, NT = F.G * NWAVES * 64;
      for (int idx = gt; idx < M * 32; idx += NT) { const int m = idx >> 5, d = idx & 31;
          const double rev = (double)P.pos[m] * INV_REV[d]; const double fr = rev - __builtin_rint(rev); const float ang = (float)(fr * 6.283185307179586476925);
          float sn, cn; sn = sinf(ang); cn = cosf(ang);
          P.cs[(size_t)m * 64 + (d >> 2) * 8 + (d & 3)] = cn; P.cs[(size_t)m * 64 + (d >> 2) * 8 + 4 + (d & 3)] = sn; }
      for (int e = gt; e < 4 * 128 * 128; e += NT) { const int i = (e >> 7) & 127, j = e & 127; P.wsm[e] = (bf16)(((i >> 6) >= (j >> 6)) ? f2bf(P.gws[e]) : 0u); } }
    if (F.vcu < NGEMV_WG) {
        LAS float* csl = (LAS float*)(F.lds + RING_OFF);
        LAS float* red = csl + 2048;
        for (int i = F.tid; i < 2048; i += NWAVES * 64) { const float v = P.c[i]; csl[i] = v / (1.0f + __expf(-v)); }
        __syncthreads();
        const int n = F.vcu * 64 + F.lane, kb = F.wave * 128; float a0 = 0.f, a1 = 0.f;
#pragma unroll 16
        for (int k = 0; k < 128; ++k) { const float w = P.w_ada[(size_t)(kb + k) * 3072 + n]; a0 += csl[kb + k] * w; a1 += csl[1024 + kb + k] * w; }
        red[(F.wave * 2 + 0) * 64 + F.lane] = a0; red[(F.wave * 2 + 1) * 64 + F.lane] = a1;
        __syncthreads();
        if (F.tid < 128) { const int b = F.tid >> 6, l = F.tid & 63; float s = P.b_ada[F.vcu * 64 + l];
#pragma unroll
            for (int w = 0; w < 8; ++w) s += red[(w * 2 + b) * 64 + l];
            P.mod[b * 3072 + F.vcu * 64 + l] = s; }
        __syncthreads();
    } else {
        LAS float* scr = (LAS float*)(F.lds + RING_OFF + F.wave * 16384);
        const int gw = (F.vcu - NGEMV_WG) * NWAVES + F.wave, NGW = (F.G - NGEMV_WG) * NWAVES;
        constexpr int I_IN = (DM / 64) * (DIN / 32), I_OUT = (DM / 64) * (DM / 32);
        for (int it = gw; it < I_IN + I_OUT; it += NGW) {
            if (it < I_IN) p0_transpose_item<true>(P.w_in, DM, DIN, P.win_t, scr, it, F.lane);
            else p0_transpose_item<false>(P.w_out, DM, DM, P.wout_t, scr, it - I_IN, F.lane);
        }
    }
}
__device__ __forceinline__ void p1_hrows(Frame& F, const Ptrs& P) {
    const int gw = F.vcu * NWAVES + F.wave, NGW = F.G * NWAVES;
    for (int blk = gw; blk < M / 8; blk += NGW) {
        const int b = (blk * 8) / SEQ; const float* shift = P.mod + b * 3072; const float* scale = shift + 1024;
        f32x4 gs[4], sh[4];
#pragma unroll
        for (int j = 0; j < 4; ++j) { const f32x4 g = *(const f32x4*)(P.norm_g + 4 * F.lane + 256 * j), sc = *(const f32x4*)(scale + 4 * F.lane + 256 * j); gs[j] = g * (sc + 1.0f); sh[j] = *(const f32x4*)(shift + 4 * F.lane + 256 * j); }
        for (int rr = 0; rr < 8; ++rr) {
            const size_t m = (size_t)blk * 8 + rr;
            const GAS f32x4* xr = (const GAS f32x4*)(P.x + m * DM) + F.lane;
            f32x4 v[4]; float s = 0.f;
#pragma unroll
            for (int j = 0; j < 4; ++j) { v[j] = xr[64 * j]; s += (v[j].x * v[j].x + v[j].y * v[j].y) + (v[j].z * v[j].z + v[j].w * v[j].w); }
            const float rinv = 1.0f / sqrtf(wave_sum(s) * (1.0f / DM) + EPS);
            GAS unsigned long long* o8 = (GAS unsigned long long*)(P.H + m * DM) + F.lane;
#pragma unroll
            for (int j = 0; j < 4; ++j) { const f32x4 y = v[j] * rinv * gs[j] + sh[j]; o8[64 * j] = (unsigned long long)pk2(y.x, y.y) | ((unsigned long long)pk2(y.z, y.w) << 32); }
        }
    }
}
__device__ __forceinline__ void p5_final(Frame& F, const Ptrs& P) {
    const int gw = F.vcu * NWAVES + F.wave, NGW = F.G * NWAVES;
    f32x4 fg[4];
#pragma unroll
    for (int j = 0; j < 4; ++j) fg[j] = *(const f32x4*)(P.fin_g + 4 * F.lane + 256 * j);
    for (int m = gw; m < M; m += NGW) {
        GAS f32x4* xr = (GAS f32x4*)(P.out + (size_t)m * DM) + F.lane;
        f32x4 v[4]; float s = 0.f;
#pragma unroll
        for (int j = 0; j < 4; ++j) { v[j] = xr[64 * j]; s += (v[j].x * v[j].x + v[j].y * v[j].y) + (v[j].z * v[j].z + v[j].w * v[j].w); }
        const float rinv = 1.0f / sqrtf(wave_sum(s) * (1.0f / DM) + EPS);
#pragma unroll
        for (int j = 0; j < 4; ++j) xr[64 * j] = v[j] * rinv * fg[j];
    }
}

#ifndef REP_P0
#define REP_P0 1
#endif
#ifndef REP_P1
#define REP_P1 1
#endif
#ifndef REP_P2
#define REP_P2 1
#endif
#ifndef REP_P3A
#define REP_P3A 1
#endif
#ifndef REP_P3G
#define REP_P3G 1
#endif
#ifndef REP_P4
#define REP_P4 1
#endif
struct Args { const void* in[18]; float* out; unsigned char* ws; int ph_lo, ph_hi, li, pad; };
__global__ void __launch_bounds__(NWAVES * 64, 2) blk_fwd(Args args) {
    extern __shared__ __attribute__((aligned(16))) unsigned char lds[];
    Frame F;
    F.lds = (LAS unsigned char*)lds;
    F.MISC = (volatile LAS unsigned*)(F.lds + MISC_OFF);
    F.tid = threadIdx.x; F.lane = F.tid & 63; F.wave = __builtin_amdgcn_readfirstlane(F.tid >> 6);
    F.G = gridDim.x; { const int bx = blockIdx.x; F.vcu = (F.G % 8 == 0) ? (bx % 8) * (F.G / 8) + bx / 8 : bx; }
    unsigned char* ws = args.ws;
    F.ctl = (gu32*)(ws + WS_CTL);
    Ptrs P;
    P.x = (const float*)args.in[0]; P.c = (const float*)args.in[1]; P.pos = (const int*)args.in[2]; P.w_ada = (const float*)args.in[3]; P.b_ada = (const float*)args.in[4];
    P.norm_g = (const float*)args.in[5]; P.w_in = (const float*)args.in[6]; P.ln_g = (const float*)args.in[7]; P.ln_b = (const float*)args.in[8]; P.gws = (const float*)args.in[9];
    P.gbs = (const float*)args.in[10]; P.lq1 = (const float*)args.in[11]; P.lk1 = (const float*)args.in[12]; P.lq2 = (const float*)args.in[13]; P.lk2 = (const float*)args.in[14];
    P.subg = (const float*)args.in[15]; P.w_out = (const float*)args.in[16]; P.fin_g = (const float*)args.in[17];
    P.out = args.out; P.mod = (float*)(ws + WS_MOD); P.cs = (float*)(ws + WS_CS); P.win_t = (bf16*)(ws + WS_WIN); P.wout_t = (bf16*)(ws + WS_WOUT); P.wsm = (bf16*)(ws + WS_WSM);
    P.H = (bf16*)(ws + WS_H); P.proj = (bf16*)(ws + WS_PROJ); P.Y = (bf16*)(ws + WS_Y);
    for (int u = F.tid; u < (LDS_BYTES - LDSCTL_OFF) / 4; u += NWAVES * 64) ((LAS unsigned*)(F.lds + LDSCTL_OFF))[u] = 0u;
    __syncthreads();
    XcdBarrier bar; bar.bar = (unsigned*)(F.ctl + CW_BAR); bar.x = 0; bar.st = nullptr;
    if (N_LAUNCHES != PER_PHASE) bar = xcd_barrier_post((unsigned*)(F.ctl + CW_BAR), F.MISC + 8);
#define GRID_BAR() do { if (N_LAUNCHES != PER_PHASE) xcd_barrier(bar); } while (0)
    const int lo = args.ph_lo, hi = args.ph_hi;
#define IN(k) (lo <= (k) && (k) < hi)
#define BOTH(k) (IN(k) && IN((k) + 1))

    if (IN(0)) { for (int rep = 0; rep < REP_P0; ++rep) { p0_prologue(F, P); if (rep + 1 < REP_P0) __syncthreads(); } if (BOTH(0)) GRID_BAR(); }
    if (IN(1)) { for (int rep = 0; rep < REP_P1; ++rep) p1_hrows(F, P); if (BOTH(1)) GRID_BAR(); }
    if (IN(2)) {
        pg8::Gemm g{P.H, P.win_t, M, DIN, DM}; pg8::StaticOrder S; S.init(M, DIN, F.G, (int)blockIdx.x);
        pg8::EpiProj E{P.proj, P.cs};
        for (int rep = 0; rep < REP_P2; ++rep) pg8::gemm_phase<pg8::EpiProj, pg8::StaticOrder, true, true>(F.lds + RING_OFF, g, S, E);
        if (BOTH(2)) GRID_BAR();
    }
    if (IN(3)) {
        float lam; { float s1 = 0.f, s2 = 0.f;
            for (int d = 0; d < HD; ++d) { s1 += P.lq1[d] * P.lk1[d]; s2 += P.lq2[d] * P.lk2[d]; } lam = __expf(s1) - __expf(s2) + LAM_INIT; }
        const bf16* Qb = P.proj + 3 * BUF_STRIDE; const bf16* Kb = P.proj + 4 * BUF_STRIDE; const bf16* Vb = P.proj + 5 * BUF_STRIDE; const bf16* SZB = P.proj + 6 * BUF_STRIDE;
        for (int rep = 0; rep < REP_P3A; ++rep)
        for (int v = F.vcu; v < 256; v += F.G) {
            const int bh = v >> 5, s = v & 31;
            att::attn_unit_p<8>(bh >> 2, bh & 3, s, Qb, Kb, Vb, SZB, P.Y, P.subg, lam, (char*)lds + RING_OFF);
            att::attn_unit_p<8>(bh >> 2, bh & 3, 63 - s, Qb, Kb, Vb, SZB, P.Y, P.subg, lam, (char*)lds + RING_OFF);
        }
        for (int rep = 0; rep < REP_P3G; ++rep)
        for (int it = F.vcu; it < 512; it += F.G)
            att::gmlp_unit(it >> 2, it & 3, P.proj, P.proj + BUF_STRIDE, P.proj + 2 * BUF_STRIDE, P.wsm, P.ln_g, P.ln_b, P.gbs, P.Y, (char*)lds + RING_OFF);
        if (BOTH(3)) GRID_BAR();
    }
    if (IN(4)) {
        pg8::Gemm g{P.Y, P.wout_t, M, DM, DM}; pg8::StaticOrder S; S.init(M, DM, F.G, (int)blockIdx.x);
        pg8::EpiOut E{P.x, P.out, P.mod + 2 * DM};
        for (int rep = 0; rep < REP_P4; ++rep) pg8::gemm_phase<pg8::EpiOut, pg8::StaticOrder, true, true>(F.lds + RING_OFF, g, S, E);
        if (BOTH(4)) GRID_BAR();
    }
    if (IN(5)) { p5_final(F, P); }
#undef IN
#undef BOTH
}

extern "C" void kernel_launch(void* const* d_in, const int* in_sizes, int n_in, void* d_out, int out_size, void* d_ws, size_t ws_size, hipStream_t stream) {
    static int grid = 0;
    if (grid == 0) {
        if (n_in != 18 || out_size != M * DM || ws_size < WS_END) { fprintf(stderr, "kernel_launch: unexpected shapes (n_in %d, out %d, ws %zu)\n", n_in, out_size, ws_size); grid = -1; return; }
        int dev = 0, cus = 0, per_cu = 0;
        if (hipGetDevice(&dev) != hipSuccess || hipDeviceGetAttribute(&cus, hipDeviceAttributeMultiprocessorCount, dev) != hipSuccess) { grid = -1; return; }
        if (hipFuncSetAttribute((const void*)blk_fwd, hipFuncAttributeMaxDynamicSharedMemorySize, LDS_BYTES) != hipSuccess) { fprintf(stderr, "kernel_launch: hipFuncSetAttribute failed\n"); grid = -1; return; }
        if (hipOccupancyMaxActiveBlocksPerMultiprocessor(&per_cu, (const void*)blk_fwd, NWAVES * 64, LDS_BYTES) != hipSuccess || per_cu < 1)
            fprintf(stderr, "kernel_launch: note: occupancy query reports %d workgroups per CU\n", per_cu);
        (void)hipGetLastError();
        grid = cus;
        if (grid > 256) grid = 256;
    }
    if (grid < 0) return;
    if (hipMemsetAsync((char*)d_ws + WS_CTL, 0, CTL_ZERO_BYTES, stream) != hipSuccess) { fprintf(stderr, "kernel_launch: memset failed\n"); return; }
    Args a{};
    for (int i = 0; i < 18; ++i) a.in[i] = d_in[i];
    a.out = (float*)d_out; a.ws = (unsigned char*)d_ws;
    for (int li = 0; li < N_LAUNCHES; ++li) {
        a.ph_lo = (N_LAUNCHES == PER_PHASE) ? li : 0; a.ph_hi = (N_LAUNCHES == PER_PHASE) ? li + 1 : PER_PHASE; a.li = li;
        hipLaunchKernelGGL(blk_fwd, dim3(grid), dim3(NWAVES * 64), LDS_BYTES, stream, a);
        const hipError_t le = hipPeekAtLastError();
        if (le != hipSuccess) { fprintf(stderr, "kernel_launch: launch %d failed: %s\n", li, hipGetErrorName(le)); break; }
    }
}
```
